# Optimizing an MI355X kernel written in HIP

```python
import math
import jax, jax.numpy as jnp
from jax import lax
import numpy as np


D_MODEL = 1024
BATCH = 2
SEQ = 8192
DEPTH = 1

MEM_LEN = 256
EPS = 1e-6
ROPE_BASE = 10000.0

RET_HEADS = 8
RET_QK_WIDTH = D_MODEL // 2
RET_V_WIDTH = D_MODEL
RET_DK = RET_QK_WIDTH // RET_HEADS
RET_DV = RET_V_WIDTH // RET_HEADS
CHUNK = 128

S5_WIDTH = D_MODEL
S5_GROUP = 16
S5_GROUPS = S5_WIDTH // S5_GROUP
S5_STATE = 64

D_MIX = RET_V_WIDTH + S5_WIDTH
IN_COLS = 2 * RET_QK_WIDTH + 2 * RET_V_WIDTH + 2 * S5_WIDTH
SPLITS = (RET_QK_WIDTH, 2 * RET_QK_WIDTH, 2 * RET_QK_WIDTH + RET_V_WIDTH,
          2 * RET_QK_WIDTH + 2 * RET_V_WIDTH, 2 * RET_QK_WIDTH + 2 * RET_V_WIDTH + S5_WIDTH)

XA_HEADS = 4
XA_DH = D_MODEL // XA_HEADS

kernel_name = 'hybrid_retention_s5_block'


def rms_norm(x, g):
    xf = x.astype(jnp.float32)
    y = xf * lax.rsqrt(jnp.mean(xf * xf, axis=-1, keepdims=True) + EPS)
    return (y * g.astype(jnp.float32)).astype(x.dtype)


def rotary(x, positions):
    half = x.shape[-1] // 2
    inv = ROPE_BASE ** (-jnp.arange(half, dtype=jnp.float32) / half)
    ang = positions.astype(jnp.float32)[:, :, None, None] * inv
    cos, sin = jnp.cos(ang), jnp.sin(ang)
    x1, x2 = x[..., :half], x[..., half:]
    return jnp.concatenate([x1 * cos - x2 * sin, x1 * sin + x2 * cos], axis=-1)


def retention(q, k, v, gn_g):
    B, L, H, DK = q.shape
    DV = v.shape[-1]
    nC = L // CHUNK
    q = q.astype(jnp.float32)
    k = k.astype(jnp.float32) * DK ** -0.5
    v = v.astype(jnp.float32)
    log_g = jnp.log1p(-jnp.exp2(-5.0 - jnp.arange(H, dtype=jnp.float32)))
    qc = q.reshape(B, nC, CHUNK, H, DK)
    kc = k.reshape(B, nC, CHUNK, H, DK)
    vc = v.reshape(B, nC, CHUNK, H, DV)
    j = jnp.arange(CHUNK, dtype=jnp.float32)
    diff = j[:, None] - j[None, :]
    decay = jnp.where(diff[None] >= 0.0,
                      jnp.exp(log_g[:, None, None] * jnp.maximum(diff, 0.0)[None]), 0.0)
    scores = jnp.einsum('bnihd,bnjhd->bnhij', qc, kc) * decay
    inner = jnp.einsum('bnhij,bnjhe->bnihe', scores, vc)
    k_w = jnp.exp(log_g[None, :] * (CHUNK - 1.0 - j)[:, None])
    kv = jnp.einsum('bnjhd,jh,bnjhe->bnhde', kc, k_w, vc)
    chunk_decay = jnp.exp(log_g * CHUNK)[None, :, None, None]

    def step(R, kv_n):
        return chunk_decay * R + kv_n, R

    _, R_prev = lax.scan(step, jnp.zeros((B, H, DK, DV), jnp.float32), jnp.moveaxis(kv, 1, 0))
    R_prev = jnp.moveaxis(R_prev, 0, 1)
    q_w = jnp.exp(log_g[None, :] * (j + 1.0)[:, None])
    cross = jnp.einsum('bnihd,ih,bnhde->bnihe', qc, q_w, R_prev)
    o = (inner + cross).reshape(B, L, H, DV)
    mu = jnp.mean(o, axis=-1, keepdims=True)
    var = jnp.mean(jnp.square(o - mu), axis=-1, keepdims=True)
    o = ((o - mu) * lax.rsqrt(var + EPS)).reshape(B, L, H * DV)
    return o * gn_g.astype(jnp.float32)


def s5_branch(u, a_re, a_im, log_dt, b_re, b_im, c_re, c_im, d, glu_w, glu_b):
    Bsz, L, W = u.shape
    f32 = jnp.float32
    uf = u.astype(f32)
    ug = uf.reshape(Bsz, L, S5_GROUPS, S5_GROUP)
    dt = jnp.exp(log_dt.astype(f32))[:, None]
    ar, ai = a_re.astype(f32), a_im.astype(f32)
    mag = jnp.exp(ar * dt)
    abar_re = mag * jnp.cos(ai * dt)
    abar_im = mag * jnp.sin(ai * dt)
    den = ar * ar + ai * ai
    nr, ni = abar_re - 1.0, abar_im
    f_re = (nr * ar + ni * ai) / den
    f_im = (ni * ar - nr * ai) / den
    br, bi = b_re.astype(f32), b_im.astype(f32)
    bb_re = f_re[..., None] * br - f_im[..., None] * bi
    bb_im = f_re[..., None] * bi + f_im[..., None] * br
    bu_re = jnp.einsum('blgp,gnp->blgn', ug, bb_re)
    bu_im = jnp.einsum('blgp,gnp->blgn', ug, bb_im)
    a_seq_re = jnp.broadcast_to(abar_re[None, None], (1, L, S5_GROUPS, S5_STATE))
    a_seq_im = jnp.broadcast_to(abar_im[None, None], (1, L, S5_GROUPS, S5_STATE))

    def combine(e1, e2):
        a1r, a1i, b1r, b1i = e1
        a2r, a2i, b2r, b2i = e2
        return (a2r * a1r - a2i * a1i,
                a2r * a1i + a2i * a1r,
                a2r * b1r - a2i * b1i + b2r,
                a2r * b1i + a2i * b1r + b2i)

    _, _, xr, xi = lax.associative_scan(combine, (a_seq_re, a_seq_im, bu_re, bu_im), axis=1)
    y = (jnp.einsum('blgn,gpn->blgp', xr, c_re.astype(f32))
         - jnp.einsum('blgn,gpn->blgp', xi, c_im.astype(f32)))
    y = y.reshape(Bsz, L, W) + d.astype(f32) * uf
    y = jax.nn.gelu(y)
    y = y * jax.nn.sigmoid(y @ glu_w.astype(f32) + glu_b.astype(f32))
    return y


def setup_inputs(seed: int = 0) -> dict:
    key = jax.random.key(seed)
    ks = jax.random.split(key, 24)
    f32 = jnp.float32

    def nrm(k, shape, scale):
        return jax.random.normal(k, shape, f32) * scale

    Ld = DEPTH
    G, N, P = S5_GROUPS, S5_STATE, S5_GROUP
    x = nrm(ks[0], (BATCH, SEQ, D_MODEL), 1.0)
    mem = nrm(ks[1], (BATCH, MEM_LEN, D_MODEL), 1.0)
    positions = jnp.broadcast_to(jnp.arange(SEQ, dtype=jnp.int32)[None, :], (BATCH, SEQ))
    norm1_g = 1.0 + nrm(ks[2], (Ld, D_MODEL), 0.02)
    w_in = nrm(ks[3], (Ld, D_MODEL, IN_COLS), D_MODEL ** -0.5)
    ret_gn_g = 1.0 + nrm(ks[4], (Ld, RET_V_WIDTH), 0.02)
    n_idx = jnp.arange(N, dtype=f32)
    s5_a_re = -0.5 + nrm(ks[5], (Ld, G, N), 0.01)
    s5_a_im = math.pi * n_idx[None, None, :] + nrm(ks[6], (Ld, G, N), 0.01)
    s5_log_dt = jax.random.uniform(ks[7], (Ld, G), f32, math.log(1e-3), math.log(1e-1))
    s5_b_re = nrm(ks[8], (Ld, G, N, P), (2.0 * P) ** -0.5)
    s5_b_im = nrm(ks[9], (Ld, G, N, P), (2.0 * P) ** -0.5)
    s5_c_re = nrm(ks[10], (Ld, G, P, N), N ** -0.5)
    s5_c_im = nrm(ks[11], (Ld, G, P, N), N ** -0.5)
    s5_d = nrm(ks[12], (Ld, S5_WIDTH), 0.5)
    s5_glu_w = nrm(ks[13], (Ld, S5_WIDTH, S5_WIDTH), S5_WIDTH ** -0.5)
    s5_glu_b = nrm(ks[14], (Ld, S5_WIDTH), 0.01)
    w_out = nrm(ks[15], (Ld, D_MIX, D_MODEL), D_MIX ** -0.5)
    norm2_g = 1.0 + nrm(ks[16], (Ld, D_MODEL), 0.02)
    norm_mem_g = 1.0 + nrm(ks[17], (Ld, D_MODEL), 0.02)
    xa_wq = nrm(ks[18], (Ld, D_MODEL, D_MODEL), D_MODEL ** -0.5)
    xa_wk = nrm(ks[19], (Ld, D_MODEL, D_MODEL), D_MODEL ** -0.5)
    xa_wv = nrm(ks[20], (Ld, D_MODEL, D_MODEL), D_MODEL ** -0.5)
    xa_wo = nrm(ks[21], (Ld, D_MODEL, D_MODEL), D_MODEL ** -0.5)
    norm_f_g = 1.0 + nrm(ks[22], (D_MODEL,), 0.02)
    return {'x': x, 'mem': mem, 'positions': positions, 'norm1_g': norm1_g, 'w_in': w_in,
            'ret_gn_g': ret_gn_g, 's5_a_re': s5_a_re, 's5_a_im': s5_a_im, 's5_log_dt': s5_log_dt,
            's5_b_re': s5_b_re, 's5_b_im': s5_b_im, 's5_c_re': s5_c_re, 's5_c_im': s5_c_im,
            's5_d': s5_d, 's5_glu_w': s5_glu_w, 's5_glu_b': s5_glu_b, 'w_out': w_out,
            'norm2_g': norm2_g, 'norm_mem_g': norm_mem_g, 'xa_wq': xa_wq, 'xa_wk': xa_wk,
            'xa_wv': xa_wv, 'xa_wo': xa_wo, 'norm_f_g': norm_f_g}


def reference(x, mem, positions, norm1_g, w_in, ret_gn_g, s5_a_re, s5_a_im, s5_log_dt,
              s5_b_re, s5_b_im, s5_c_re, s5_c_im, s5_d, s5_glu_w, s5_glu_b, w_out,
              norm2_g, norm_mem_g, xa_wq, xa_wk, xa_wv, xa_wo, norm_f_g):
    B, L, _ = x.shape
    M = mem.shape[1]
    for l in range(DEPTH):
        h = rms_norm(x, norm1_g[l])
        proj = h @ w_in[l]
        q, k, v, g_ret, u, g_s5 = jnp.split(proj, SPLITS, axis=-1)
        q = rotary(q.reshape(B, L, RET_HEADS, RET_DK), positions)
        k = rotary(k.reshape(B, L, RET_HEADS, RET_DK), positions)
        v = v.reshape(B, L, RET_HEADS, RET_DV)
        ret = retention(q, k, v, ret_gn_g[l]).astype(x.dtype) * jax.nn.silu(g_ret)
        ssm = s5_branch(u, s5_a_re[l], s5_a_im[l], s5_log_dt[l], s5_b_re[l], s5_b_im[l],
                        s5_c_re[l], s5_c_im[l], s5_d[l], s5_glu_w[l],
                        s5_glu_b[l]).astype(x.dtype) * jax.nn.silu(g_s5)
        x = x + jnp.concatenate([ret, ssm], axis=-1) @ w_out[l]
        h2 = rms_norm(x, norm2_g[l])
        m = rms_norm(mem, norm_mem_g[l])
        qa = (h2 @ xa_wq[l]).reshape(B, L, XA_HEADS, XA_DH)
        ka = (m @ xa_wk[l]).reshape(B, M, XA_HEADS, XA_DH)
        va = (m @ xa_wv[l]).reshape(B, M, XA_HEADS, XA_DH)
        s = jnp.einsum('blhd,bmhd->bhlm', qa, ka).astype(jnp.float32) * XA_DH ** -0.5
        p = jax.nn.softmax(s, axis=-1).astype(va.dtype)
        o = jnp.einsum('bhlm,bmhd->blhd', p, va).reshape(B, L, XA_HEADS * XA_DH)
        x = x + o @ xa_wo[l]
    return rms_norm(x, norm_f_g)
```

```cpp
#include <hip/hip_runtime.h>
#include <cstdint>
#include <cstdio>

typedef unsigned short bf16;
typedef float f32x4 __attribute__((ext_vector_type(4)));
typedef unsigned u32x4 __attribute__((ext_vector_type(4)));

constexpr int D = 1024, BATCH = 2, SEQ = 8192, M = BATCH * SEQ, MEM = 256, MM = BATCH * MEM;
constexpr int RH = 8, RDK = 64, RDV = 128, CHUNK = 128, NCH = SEQ / CHUNK;
constexpr int SG = 64, SN = 64, SP = 16;
constexpr int INC = 5120, DMIX = 2048, XH = 4, XDH = 256;
constexpr float EPS = 1e-6f;

constexpr size_t MiB = 1u << 20;
constexpr size_t WS_CTL = 0, WS_ROPE = 1 * MiB, WS_S5P = 5 * MiB, WS_MISC = 6 * MiB;
constexpr size_t WS_Q = 32 * MiB, WS_K = 48 * MiB, WS_VU = 64 * MiB, WS_GR = 128 * MiB, WS_GS = 160 * MiB, WS_KVST = 192 * MiB;
constexpr size_t WS_MB = 224 * MiB, WS_KA = 225 * MiB, WS_VA = 226 * MiB;
constexpr size_t WS_X1B = WS_Q, WS_OA = WS_GR, WS_QA = WS_VU;
constexpr int S5P_AR = 0, S5P_AI = 4096, S5P_BR = 8192, S5P_BI = 8192 + 65536;

__device__ __forceinline__ float bf2f(bf16 v) { return __uint_as_float(((unsigned)v) << 16); }
__device__ __forceinline__ bf16 f2bf(float f) { unsigned u = __float_as_uint(f); return (bf16)((u + 0x7fffu + ((u >> 16) & 1u)) >> 16); }
__device__ __forceinline__ float sigmoidf_(float x) { return 1.f / (1.f + __expf(-x)); }
__device__ __forceinline__ float siluf_(float x) { return x * sigmoidf_(x); }
__device__ __forceinline__ float gelu_tanh(float x) { const float u = 0.7978845608028654f * (x + 0.044715f * x * x * x); return 0.5f * x * (1.f + tanhf(u)); }
__device__ __forceinline__ float wave_sum(float v) {
#pragma unroll
    for (int o = 1; o < 64; o <<= 1) v += __shfl_xor(v, o);
    return v;
}
__device__ __forceinline__ float wave_max(float v) {
#pragma unroll
    for (int o = 1; o < 64; o <<= 1) v = fmaxf(v, __shfl_xor(v, o));
    return v;
}

__global__ __launch_bounds__(256) void k_rmsnorm_bf16(const float* __restrict__ x, bf16* __restrict__ out, int rows) {
    const int w = (blockIdx.x * 256 + threadIdx.x) >> 6, lane = threadIdx.x & 63;
    if (w >= rows) return;
    const f32x4* xr = (const f32x4*)(x + (size_t)w * D) + lane;
    f32x4 v[4]; float s = 0.f;
#pragma unroll
    for (int j = 0; j < 4; ++j) { v[j] = xr[64 * j]; s += v[j].x * v[j].x + v[j].y * v[j].y + v[j].z * v[j].z + v[j].w * v[j].w; }
    const float rstd = rsqrtf(wave_sum(s) * (1.f / D) + EPS);
    uint2* o = (uint2*)(out + (size_t)w * D) + lane;
#pragma unroll
    for (int j = 0; j < 4; ++j) {
        uint2 p; p.x = (unsigned)f2bf(v[j].x * rstd) | ((unsigned)f2bf(v[j].y * rstd) << 16); p.y = (unsigned)f2bf(v[j].z * rstd) | ((unsigned)f2bf(v[j].w * rstd) << 16);
        o[64 * j] = p;
    }
}
__global__ void k_rope_table(const int* __restrict__ pos, float2* __restrict__ tab) {
    const int idx = blockIdx.x * blockDim.x + threadIdx.x;
    if (idx >= M * 32) return;
    const int t = idx >> 5, i = idx & 31;
    const float inv = powf(10000.0f, -(float)i / 32.0f);
    const float ang = (float)pos[t] * inv;
    float s, c; sincosf(ang, &s, &c);
    tab[idx] = make_float2(c, s);
}
__global__ void k_s5_params(const float* __restrict__ a_re, const float* __restrict__ a_im, const float* __restrict__ log_dt,
                            const float* __restrict__ b_re, const float* __restrict__ b_im, float* __restrict__ P) {
    const int idx = blockIdx.x * blockDim.x + threadIdx.x;
    if (idx >= SG * SN) return;
    const int g = idx / SN;
    const float dt = expf(log_dt[g]), ar = a_re[idx], ai = a_im[idx];
    const float mag = expf(ar * dt);
    float sn, cs; sincosf(ai * dt, &sn, &cs);
    const float abr = mag * cs, abi = mag * sn;
    const float den = ar * ar + ai * ai, nr = abr - 1.f, ni = abi;
    const float fr = (nr * ar + ni * ai) / den, fi = (ni * ar - nr * ai) / den;
    P[S5P_AR + idx] = abr; P[S5P_AI + idx] = abi;
    for (int p = 0; p < SP; ++p) {
        const float br = b_re[idx * SP + p], bi = b_im[idx * SP + p];
        P[S5P_BR + idx * SP + p] = fr * br - fi * bi;
        P[S5P_BI + idx * SP + p] = fr * bi + fi * br;
    }
}

struct ALoadBf { const bf16* A; const float* ks; int lda; int pad; __device__ __forceinline__ float operator()(int r, int k) const { float v = bf2f(A[(size_t)r * lda + k]); return ks ? v * ks[k] : v; } };
struct BLoadPlain { const float* W; int ldw; int pad; __device__ __forceinline__ float operator()(int k, int c) const { return W[(size_t)k * ldw + c]; } };
struct BLoadInproj { const float* W; __device__ __forceinline__ float operator()(int k, int c) const {
        int oc = c; if (c < 1024) { const int cc = c & 63; oc = (c - cc) + (cc >> 1) + 32 * (cc & 1); } return W[(size_t)k * INC + oc]; } };

template <class AL, class BL, class EP>
__global__ __launch_bounds__(256) void k_gemm_naive(int Mr, int N, int K, int pad_, AL al, BL bl, EP ep) {
    __shared__ float As[16][68], Bs[16][68];
    const int tid = threadIdx.x, tx = tid & 15, ty = tid >> 4;
    const int row0 = blockIdx.y * 64, col0 = blockIdx.x * 64;
    float acc[4][4];
#pragma unroll
    for (int i = 0; i < 4; ++i)
#pragma unroll
        for (int j = 0; j < 4; ++j) acc[i][j] = 0.f;
    for (int k0 = 0; k0 < K; k0 += 16) {
#pragma unroll
        for (int i = 0; i < 4; ++i) { const int e = tid + 256 * i; const int r = e >> 4, k = e & 15; As[k][r] = al(row0 + r, k0 + k); }
#pragma unroll
        for (int i = 0; i < 4; ++i) { const int e = tid + 256 * i; const int k = e >> 6, c = e & 63; Bs[k][c] = bl(k0 + k, col0 + c); }
        __syncthreads();
#pragma unroll
        for (int k = 0; k < 16; ++k) {
            const f32x4 a = *(const f32x4*)&As[k][ty * 4]; const f32x4 b = *(const f32x4*)&Bs[k][tx * 4];
#pragma unroll
            for (int i = 0; i < 4; ++i)
#pragma unroll
                for (int j = 0; j < 4; ++j) acc[i][j] += a[i] * b[j];
        }
        __syncthreads();
    }
#pragma unroll
    for (int i = 0; i < 4; ++i) { float v[4] = {acc[i][0], acc[i][1], acc[i][2], acc[i][3]}; ep(row0 + ty * 4 + i, col0 + tx * 4, v); }
}
__device__ __forceinline__ void st4bf(bf16* p, const float* v) { uint2 o; o.x = (unsigned)f2bf(v[0]) | ((unsigned)f2bf(v[1]) << 16); o.y = (unsigned)f2bf(v[2]) | ((unsigned)f2bf(v[3]) << 16); *(uint2*)p = o; }

struct EpInproj {
    bf16 *Q, *Kb, *VU, *GR, *GS; const float2* rope;
    __device__ __forceinline__ void operator()(int r, int c, float* v) const {
        if (c < 1024) {
            const bool isk = c >= 512; const int cc = c & 511; const int i0 = (cc & 63) >> 1;
            const float2 cs0 = rope[r * 32 + i0], cs1 = rope[r * 32 + i0 + 1];
            float o[4]; o[0] = v[0] * cs0.x - v[1] * cs0.y; o[1] = v[0] * cs0.y + v[1] * cs0.x; o[2] = v[2] * cs1.x - v[3] * cs1.y; o[3] = v[2] * cs1.y + v[3] * cs1.x;
            if (isk) { o[0] *= 0.125f; o[1] *= 0.125f; o[2] *= 0.125f; o[3] *= 0.125f; }
            st4bf((isk ? Kb : Q) + (size_t)r * 512 + cc, o);
        } else if (c < 2048) st4bf(VU + (size_t)r * 2048 + (c - 1024), v);
        else if (c < 3072) { float o[4] = {siluf_(v[0]), siluf_(v[1]), siluf_(v[2]), siluf_(v[3])}; st4bf(GR + (size_t)r * 1024 + (c - 2048), o); }
        else if (c < 4096) st4bf(VU + (size_t)r * 2048 + 1024 + (c - 3072), v);
        else { float o[4] = {siluf_(v[0]), siluf_(v[1]), siluf_(v[2]), siluf_(v[3])}; st4bf(GS + (size_t)r * 1024 + (c - 4096), o); }
    }
};
struct EpGlu {
    const bf16* YG; const bf16* GS; const float* bias; bf16* VU;
    __device__ __forceinline__ void operator()(int r, int c, float* v) const {
        float o[4];
#pragma unroll
        for (int j = 0; j < 4; ++j) o[j] = bf2f(YG[(size_t)r * 1024 + c + j]) * sigmoidf_(v[j] + bias[c + j]) * bf2f(GS[(size_t)r * 1024 + c + j]);
        st4bf(VU + (size_t)r * 2048 + 1024 + c, o);
    }
};
struct EpOut {
    const float* x; float* X1; bf16* X1B;
    __device__ __forceinline__ void operator()(int r, int c, float* v) const {
        const f32x4 xv = *(const f32x4*)(x + (size_t)r * D + c);
        float o[4] = {xv.x + v[0], xv.y + v[1], xv.z + v[2], xv.w + v[3]};
        *(f32x4*)(X1 + (size_t)r * D + c) = (f32x4){o[0], o[1], o[2], o[3]};
        st4bf(X1B + (size_t)r * D + c, o);
    }
};
struct EpScaleRow {
    bf16* O; const float* rs; int ldo; float s;
    __device__ __forceinline__ void operator()(int r, int c, float* v) const {
        const float f = (rs ? rs[r] : 1.f) * s; float o[4] = {v[0] * f, v[1] * f, v[2] * f, v[3] * f}; st4bf(O + (size_t)r * ldo + c, o);
    }
};
struct EpResInplace {
    float* X;
    __device__ __forceinline__ void operator()(int r, int c, float* v) const {
        f32x4* p = (f32x4*)(X + (size_t)r * D + c); f32x4 xv = *p; xv.x += v[0]; xv.y += v[1]; xv.z += v[2]; xv.w += v[3]; *p = xv;
    }
};

__device__ __forceinline__ float ret_logg(int h) { return log1pf(-exp2f(-5.0f - (float)h)); }
__global__ __launch_bounds__(256) void k_ret_kv(const bf16* __restrict__ Kb, const bf16* __restrict__ VU, float* __restrict__ KV) {
    __shared__ bf16 Ks[128][64]; __shared__ bf16 Vs[128][128];
    const int unit = blockIdx.x, h = unit & 7, n = (unit >> 3) & 63, b = unit >> 9;
    const int t0 = b * SEQ + n * CHUNK, tid = threadIdx.x;
    for (int e = tid; e < 128 * 64; e += 256) { const int j = e >> 6, d = e & 63; Ks[j][d] = Kb[(size_t)(t0 + j) * 512 + h * 64 + d]; }
    for (int e = tid; e < 128 * 128; e += 256) { const int j = e >> 7, c = e & 127; Vs[j][c] = VU[(size_t)(t0 + j) * 2048 + h * 128 + c]; }
    __syncthreads();
    const int e = tid & 127, dh = tid >> 7; const float lg = ret_logg(h);
    float acc[32];
#pragma unroll
    for (int i = 0; i < 32; ++i) acc[i] = 0.f;
    for (int j = 0; j < 128; ++j) {
        const float vv = bf2f(Vs[j][e]) * __expf(lg * (float)(127 - j));
#pragma unroll
        for (int i = 0; i < 32; ++i) acc[i] += bf2f(Ks[j][dh * 32 + i]) * vv;
    }
#pragma unroll
    for (int i = 0; i < 32; ++i) KV[(size_t)unit * 8192 + (dh * 32 + i) * 128 + e] = acc[i];
}
__global__ void k_ret_scan(float* __restrict__ KV) {
    const int idx = blockIdx.x * blockDim.x + threadIdx.x;
    if (idx >= BATCH * RH * 8192) return;
    const int de = idx & 8191, h = (idx >> 13) & 7, b = idx >> 16;
    const float cd = __expf(ret_logg(h) * (float)CHUNK);
    float R = 0.f;
    for (int n = 0; n < NCH; ++n) { float* p = KV + (size_t)((b * NCH + n) * RH + h) * 8192 + de; const float t = *p; *p = R; R = cd * R + t; }
}
__global__ __launch_bounds__(256) void k_ret_out(const bf16* __restrict__ Q, const bf16* __restrict__ Kb, bf16* __restrict__ VU, const bf16* __restrict__ GR,
                                                 const float* __restrict__ KV, const float* __restrict__ gn_g) {
    __shared__ bf16 Ks[128][64]; __shared__ bf16 Vs[128][128];
    const int unit = blockIdx.x, h = unit & 7, n = (unit >> 3) & 63, b = unit >> 9;
    const int t0 = b * SEQ + n * CHUNK, tid = threadIdx.x;
    for (int e = tid; e < 128 * 64; e += 256) { const int j = e >> 6, d = e & 63; Ks[j][d] = Kb[(size_t)(t0 + j) * 512 + h * 64 + d]; }
    for (int e = tid; e < 128 * 128; e += 256) { const int j = e >> 7, c = e & 127; Vs[j][c] = VU[(size_t)(t0 + j) * 2048 + h * 128 + c]; }
    __syncthreads();
    const int i = tid >> 1, eh = tid & 1; const float lg = ret_logg(h);
    float q[64], o[64];
#pragma unroll
    for (int d = 0; d < 64; ++d) q[d] = bf2f(Q[(size_t)(t0 + i) * 512 + h * 64 + d]);
#pragma unroll
    for (int e = 0; e < 64; ++e) o[e] = 0.f;
    for (int j = 0; j <= i; ++j) {
        float s = 0.f;
#pragma unroll
        for (int d = 0; d < 64; ++d) s += q[d] * bf2f(Ks[j][d]);
        s *= __expf(lg * (float)(i - j));
#pragma unroll
        for (int e = 0; e < 64; ++e) o[e] += s * bf2f(Vs[j][eh * 64 + e]);
    }
    const float qw = __expf(lg * (float)(i + 1));
    const float* R = KV + (size_t)unit * 8192 + eh * 64;
#pragma unroll
    for (int d = 0; d < 64; ++d) { const float qd = q[d] * qw;
#pragma unroll
        for (int e = 0; e < 64; ++e) o[e] += qd * R[d * 128 + e]; }
    float s1 = 0.f;
#pragma unroll
    for (int e = 0; e < 64; ++e) s1 += o[e];
    s1 += __shfl_xor(s1, 1); const float mu = s1 * (1.f / 128.f);
    float s2 = 0.f;
#pragma unroll
    for (int e = 0; e < 64; ++e) { const float dlt = o[e] - mu; s2 += dlt * dlt; }
    s2 += __shfl_xor(s2, 1); const float rs = rsqrtf(s2 * (1.f / 128.f) + EPS);
    const size_t ob = (size_t)(t0 + i) * 2048 + h * 128 + eh * 64, gb = (size_t)(t0 + i) * 1024 + h * 128 + eh * 64;
#pragma unroll
    for (int e = 0; e < 64; ++e) VU[ob + e] = f2bf((o[e] - mu) * rs * gn_g[h * 128 + eh * 64 + e] * bf2f(GR[gb + e]));
}

__global__ __launch_bounds__(64) void k_s5_naive(const bf16* __restrict__ VU, const float* __restrict__ P, const float* __restrict__ c_re, const float* __restrict__ c_im,
                                                 const float* __restrict__ dvec, bf16* __restrict__ YG) {
    __shared__ float us[32][16]; __shared__ float ys[32][16];
    const int g = blockIdx.x & 63, b = blockIdx.x >> 6, lane = threadIdx.x;
    float bbr[16], bbi[16], cr[16], ci[16];
#pragma unroll
    for (int p = 0; p < 16; ++p) { bbr[p] = P[S5P_BR + (g * 64 + lane) * 16 + p]; bbi[p] = P[S5P_BI + (g * 64 + lane) * 16 + p];
        cr[p] = c_re[(g * 16 + p) * 64 + lane]; ci[p] = c_im[(g * 16 + p) * 64 + lane]; }
    const float ar = P[S5P_AR + g * 64 + lane], ai = P[S5P_AI + g * 64 + lane];
    float xr = 0.f, xi = 0.f;
    for (int l0 = 0; l0 < SEQ; l0 += 32) {
        const size_t tb = (size_t)(b * SEQ + l0);
        { const int tt = lane >> 1, hh = lane & 1; const u32x4 w = *(const u32x4*)(VU + (tb + tt) * 2048 + 1024 + g * 16 + hh * 8);
          float* d = &us[tt][hh * 8];
          d[0] = __uint_as_float(w.x << 16); d[1] = __uint_as_float(w.x & 0xffff0000u); d[2] = __uint_as_float(w.y << 16); d[3] = __uint_as_float(w.y & 0xffff0000u);
          d[4] = __uint_as_float(w.z << 16); d[5] = __uint_as_float(w.z & 0xffff0000u); d[6] = __uint_as_float(w.w << 16); d[7] = __uint_as_float(w.w & 0xffff0000u); }
        __syncthreads();
        for (int s = 0; s < 32; ++s) {
            float br = 0.f, bi = 0.f;
#pragma unroll
            for (int p = 0; p < 16; ++p) { const float uu = us[s][p]; br += bbr[p] * uu; bi += bbi[p] * uu; }
            const float nxr = ar * xr - ai * xi + br, nxi = ar * xi + ai * xr + bi; xr = nxr; xi = nxi;
            float mine = 0.f;
#pragma unroll
            for (int p = 0; p < 16; ++p) { const float tot = wave_sum(cr[p] * xr - ci[p] * xi); if (lane == p) mine = tot; }
            if (lane < 16) ys[s][lane] = mine;
        }
        __syncthreads();
#pragma unroll
        for (int k = 0; k < 8; ++k) { const int e = lane + 64 * k, s = e >> 4, p = e & 15;
            const float y = ys[s][p] + dvec[g * 16 + p] * us[s][p];
            YG[(tb + s) * 1024 + g * 16 + p] = f2bf(gelu_tanh(y)); }
        __syncthreads();
    }
}

__global__ __launch_bounds__(256) void k_rstd(const float* __restrict__ x, float* __restrict__ rs, int rows) {
    const int w = (blockIdx.x * 256 + threadIdx.x) >> 6, lane = threadIdx.x & 63;
    if (w >= rows) return;
    const f32x4* xr = (const f32x4*)(x + (size_t)w * D) + lane; float s = 0.f;
#pragma unroll
    for (int j = 0; j < 4; ++j) { const f32x4 v = xr[64 * j]; s += v.x * v.x + v.y * v.y + v.z * v.z + v.w * v.w; }
    s = wave_sum(s); if (lane == 0) rs[w] = rsqrtf(s * (1.f / D) + EPS);
}
__global__ __launch_bounds__(256) void k_final_norm(float* __restrict__ x, const float* __restrict__ g, int rows) {
    const int w = (blockIdx.x * 256 + threadIdx.x) >> 6, lane = threadIdx.x & 63;
    if (w >= rows) return;
    f32x4* xr = (f32x4*)(x + (size_t)w * D) + lane; f32x4 v[4]; float s = 0.f;
#pragma unroll
    for (int j = 0; j < 4; ++j) { v[j] = xr[64 * j]; s += v[j].x * v[j].x + v[j].y * v[j].y + v[j].z * v[j].z + v[j].w * v[j].w; }
    const float rstd = rsqrtf(wave_sum(s) * (1.f / D) + EPS);
#pragma unroll
    for (int j = 0; j < 4; ++j) { const f32x4 gv = *((const f32x4*)g + lane + 64 * j); xr[64 * j] = v[j] * rstd * gv; }
}

__global__ __launch_bounds__(256) void k_xattn_naive(const bf16* __restrict__ QA, const bf16* __restrict__ KA, const bf16* __restrict__ VA, bf16* __restrict__ OA) {
    __shared__ float ps[4][256];
    const int wv = threadIdx.x >> 6, lane = threadIdx.x & 63;
    const int item = blockIdx.x * 4 + wv;
    const int h = item & 3, t = item >> 2, b = t / SEQ;
    const bf16* q = QA + (size_t)t * 1024 + h * 256;
    float sc[4];
#pragma unroll
    for (int jj = 0; jj < 4; ++jj) {
        const bf16* kr = KA + (size_t)(b * MEM + lane + 64 * jj) * 1024 + h * 256; float s = 0.f;
        for (int d = 0; d < 256; d += 8) { const u32x4 kw = *(const u32x4*)(kr + d); const u32x4 qw = *(const u32x4*)(q + d);
            s += __uint_as_float(kw.x << 16) * __uint_as_float(qw.x << 16) + __uint_as_float(kw.x & 0xffff0000u) * __uint_as_float(qw.x & 0xffff0000u)
               + __uint_as_float(kw.y << 16) * __uint_as_float(qw.y << 16) + __uint_as_float(kw.y & 0xffff0000u) * __uint_as_float(qw.y & 0xffff0000u)
               + __uint_as_float(kw.z << 16) * __uint_as_float(qw.z << 16) + __uint_as_float(kw.z & 0xffff0000u) * __uint_as_float(qw.z & 0xffff0000u)
               + __uint_as_float(kw.w << 16) * __uint_as_float(qw.w << 16) + __uint_as_float(kw.w & 0xffff0000u) * __uint_as_float(qw.w & 0xffff0000u); }
        sc[jj] = s;
    }
    const float mx = wave_max(fmaxf(fmaxf(sc[0], sc[1]), fmaxf(sc[2], sc[3])));
    float e[4], sum = 0.f;
#pragma unroll
    for (int jj = 0; jj < 4; ++jj) { e[jj] = __expf(sc[jj] - mx); sum += e[jj]; }
    sum = wave_sum(sum); const float inv = 1.f / sum;
#pragma unroll
    for (int jj = 0; jj < 4; ++jj) ps[wv][lane + 64 * jj] = e[jj] * inv;
    __syncthreads();
    float o[4] = {0.f, 0.f, 0.f, 0.f};
    for (int j = 0; j < 256; ++j) {
        const float p = ps[wv][j]; const uint2 vw = *(const uint2*)(VA + (size_t)(b * MEM + j) * 1024 + h * 256 + lane * 4);
        o[0] += p * __uint_as_float(vw.x << 16); o[1] += p * __uint_as_float(vw.x & 0xffff0000u); o[2] += p * __uint_as_float(vw.y << 16); o[3] += p * __uint_as_float(vw.y & 0xffff0000u);
    }
    st4bf(OA + (size_t)t * 1024 + h * 256 + lane * 4, o);
}

extern "C" void kernel_launch(void* const* d_in, const int* in_sizes, int n_in, void* d_out, int out_size, void* d_ws, size_t ws_size, hipStream_t stream) {
    const float* x = (const float*)d_in[0]; const float* mem = (const float*)d_in[1]; const int* pos = (const int*)d_in[2];
    const float* norm1_g = (const float*)d_in[3]; const float* w_in = (const float*)d_in[4]; const float* ret_gn_g = (const float*)d_in[5];
    const float* s5_a_re = (const float*)d_in[6]; const float* s5_a_im = (const float*)d_in[7]; const float* s5_log_dt = (const float*)d_in[8];
    const float* s5_b_re = (const float*)d_in[9]; const float* s5_b_im = (const float*)d_in[10]; const float* s5_c_re = (const float*)d_in[11]; const float* s5_c_im = (const float*)d_in[12];
    const float* s5_d = (const float*)d_in[13]; const float* s5_glu_w = (const float*)d_in[14]; const float* s5_glu_b = (const float*)d_in[15];
    const float* w_out = (const float*)d_in[16]; const float* norm2_g = (const float*)d_in[17]; const float* norm_mem_g = (const float*)d_in[18];
    const float* xa_wq = (const float*)d_in[19]; const float* xa_wk = (const float*)d_in[20]; const float* xa_wv = (const float*)d_in[21]; const float* xa_wo = (const float*)d_in[22];
    const float* norm_f_g = (const float*)d_in[23];
    unsigned char* ws = (unsigned char*)d_ws; float* out = (float*)d_out;
    bf16* HB = (bf16*)d_out; bf16* YG = (bf16*)d_out;
    float2* rope = (float2*)(ws + WS_ROPE); float* S5P = (float*)(ws + WS_S5P); float* rstd2 = (float*)(ws + WS_MISC);
    bf16* Q = (bf16*)(ws + WS_Q); bf16* Kb = (bf16*)(ws + WS_K); bf16* VU = (bf16*)(ws + WS_VU); bf16* GR = (bf16*)(ws + WS_GR); bf16* GS = (bf16*)(ws + WS_GS);
    float* KV = (float*)(ws + WS_KVST); bf16* MB = (bf16*)(ws + WS_MB); bf16* KA = (bf16*)(ws + WS_KA); bf16* VA = (bf16*)(ws + WS_VA);
    bf16* X1B = (bf16*)(ws + WS_X1B); bf16* OA = (bf16*)(ws + WS_OA); bf16* QA = (bf16*)(ws + WS_QA);

    k_rmsnorm_bf16<<<M / 4, 256, 0, stream>>>(x, HB, M);
    k_rmsnorm_bf16<<<MM / 4, 256, 0, stream>>>(mem, MB, MM);
    k_rope_table<<<M * 32 / 256, 256, 0, stream>>>(pos, rope);
    k_s5_params<<<SG * SN / 256, 256, 0, stream>>>(s5_a_re, s5_a_im, s5_log_dt, s5_b_re, s5_b_im, S5P);
    k_gemm_naive<<<dim3(INC / 64, M / 64), 256, 0, stream>>>(M, INC, D, 0, ALoadBf{HB, norm1_g, D, 0}, BLoadInproj{w_in}, EpInproj{Q, Kb, VU, GR, GS, rope});
    k_ret_kv<<<BATCH * NCH * RH, 256, 0, stream>>>(Kb, VU, KV);
    k_ret_scan<<<BATCH * RH * 8192 / 256, 256, 0, stream>>>(KV);
    k_s5_naive<<<BATCH * SG, 64, 0, stream>>>(VU, S5P, s5_c_re, s5_c_im, s5_d, YG);
    k_ret_out<<<BATCH * NCH * RH, 256, 0, stream>>>(Q, Kb, VU, GR, KV, ret_gn_g);
    k_gemm_naive<<<dim3(D / 64, M / 64), 256, 0, stream>>>(M, D, D, 0, ALoadBf{YG, nullptr, D, 0}, BLoadPlain{s5_glu_w, D, 0}, EpGlu{YG, GS, s5_glu_b, VU});
    k_gemm_naive<<<dim3(D / 64, M / 64), 256, 0, stream>>>(M, D, DMIX, 0, ALoadBf{VU, nullptr, DMIX, 0}, BLoadPlain{w_out, D, 0}, EpOut{x, out, X1B});
    k_rstd<<<M / 4, 256, 0, stream>>>(out, rstd2, M);
    k_gemm_naive<<<dim3(D / 64, M / 64), 256, 0, stream>>>(M, D, D, 0, ALoadBf{X1B, norm2_g, D, 0}, BLoadPlain{xa_wq, D, 0}, EpScaleRow{QA, rstd2, D, 0.0625f});
    k_gemm_naive<<<dim3(D / 64, MM / 64), 256, 0, stream>>>(MM, D, D, 0, ALoadBf{MB, norm_mem_g, D, 0}, BLoadPlain{xa_wk, D, 0}, EpScaleRow{KA, nullptr, D, 1.f});
    k_gemm_naive<<<dim3(D / 64, MM / 64), 256, 0, stream>>>(MM, D, D, 0, ALoadBf{MB, norm_mem_g, D, 0}, BLoadPlain{xa_wv, D, 0}, EpScaleRow{VA, nullptr, D, 1.f});
    k_xattn_naive<<<M * XH / 4, 256, 0, stream>>>(QA, KA, VA, OA);
    k_gemm_naive<<<dim3(D / 64, M / 64), 256, 0, stream>>>(M, D, D, 0, ALoadBf{OA, nullptr, D, 0}, BLoadPlain{xa_wo, D, 0}, EpResInplace{out});
    k_final_norm<<<M / 4, 256, 0, stream>>>(out, norm_f_g, M);
}
```

```cpp
#include <hip/hip_runtime.h>
#include <cstdint>
#include <cstdio>

typedef unsigned short bf16;
typedef float f32x4 __attribute__((ext_vector_type(4)));
typedef unsigned u32x4 __attribute__((ext_vector_type(4)));

constexpr int D = 1024, BATCH = 2, SEQ = 8192, M = BATCH * SEQ, MEM = 256, MM = BATCH * MEM;
constexpr int RH = 8, RDK = 64, RDV = 128, CHUNK = 128, NCH = SEQ / CHUNK;
constexpr int SG = 64, SN = 64, SP = 16;
constexpr int INC = 5120, DMIX = 2048, XH = 4, XDH = 256;
constexpr float EPS = 1e-6f;

constexpr size_t MiB = 1u << 20;
constexpr size_t WS_CTL = 0, WS_ROPE = 1 * MiB, WS_S5P = 5 * MiB, WS_MISC = 6 * MiB;
constexpr size_t WS_Q = 32 * MiB, WS_K = 48 * MiB, WS_VU = 64 * MiB, WS_GR = 128 * MiB, WS_GS = 160 * MiB, WS_KVST = 192 * MiB;
constexpr size_t WS_MB = 224 * MiB, WS_KA = 225 * MiB, WS_VA = 226 * MiB;
constexpr size_t WS_X1B = WS_Q, WS_OA = WS_GR, WS_QA = WS_VU;
constexpr int S5P_AR = 0, S5P_AI = 4096, S5P_BR = 8192, S5P_BI = 8192 + 65536;

__device__ __forceinline__ float bf2f(bf16 v) { return __uint_as_float(((unsigned)v) << 16); }
__device__ __forceinline__ bf16 f2bf(float f) { unsigned u = __float_as_uint(f); return (bf16)((u + 0x7fffu + ((u >> 16) & 1u)) >> 16); }
__device__ __forceinline__ float sigmoidf_(float x) { return 1.f / (1.f + __expf(-x)); }
__device__ __forceinline__ float siluf_(float x) { return x * sigmoidf_(x); }
__device__ __forceinline__ float gelu_tanh(float x) { const float u = 0.7978845608028654f * (x + 0.044715f * x * x * x); return 0.5f * x * (1.f + tanhf(u)); }
__device__ __forceinline__ float wave_sum(float v) {
#pragma unroll
    for (int o = 1; o < 64; o <<= 1) v += __shfl_xor(v, o);
    return v;
}
__device__ __forceinline__ float wave_max(float v) {
#pragma unroll
    for (int o = 1; o < 64; o <<= 1) v = fmaxf(v, __shfl_xor(v, o));
    return v;
}

typedef float f32x2_t __attribute__((ext_vector_type(2))); typedef __bf16 bf16x2_t __attribute__((ext_vector_type(2)));
__device__ __forceinline__ unsigned cvtpk_s(float lo, float hi) { f32x2_t v = {lo, hi}; bf16x2_t b = __builtin_convertvector(v, bf16x2_t); return __builtin_bit_cast(unsigned, b); }

__global__ __launch_bounds__(256) void k_rmsnorm_bf16(const float* __restrict__ x, bf16* __restrict__ out, int rows) {
    const int w = (blockIdx.x * 256 + threadIdx.x) >> 6, lane = threadIdx.x & 63;
    if (w >= rows) return;
    const f32x4* xr = (const f32x4*)(x + (size_t)w * D) + lane;
    f32x4 v[4]; float s = 0.f;
#pragma unroll
    for (int j = 0; j < 4; ++j) { v[j] = xr[64 * j]; s += v[j].x * v[j].x + v[j].y * v[j].y + v[j].z * v[j].z + v[j].w * v[j].w; }
    const float rstd = rsqrtf(wave_sum(s) * (1.f / D) + EPS);
    uint2* o = (uint2*)(out + (size_t)w * D) + lane;
#pragma unroll
    for (int j = 0; j < 4; ++j) {
        uint2 p; p.x = (unsigned)f2bf(v[j].x * rstd) | ((unsigned)f2bf(v[j].y * rstd) << 16); p.y = (unsigned)f2bf(v[j].z * rstd) | ((unsigned)f2bf(v[j].w * rstd) << 16);
        o[64 * j] = p;
    }
}
__global__ void k_rope_table(const int* __restrict__ pos, float2* __restrict__ tab) {
    const int idx = blockIdx.x * blockDim.x + threadIdx.x;
    if (idx >= M * 32) return;
    const int t = idx >> 5, i = idx & 31;
    const float inv = powf(10000.0f, -(float)i / 32.0f);
    const float ang = (float)pos[t] * inv;
    float s, c; sincosf(ang, &s, &c);
    tab[idx] = make_float2(c, s);
}
__global__ void k_s5_params(const float* __restrict__ a_re, const float* __restrict__ a_im, const float* __restrict__ log_dt,
                            const float* __restrict__ b_re, const float* __restrict__ b_im, float* __restrict__ P) {
    const int idx = blockIdx.x * blockDim.x + threadIdx.x;
    if (idx >= SG * SN) return;
    const int g = idx / SN;
    const float dt = expf(log_dt[g]), ar = a_re[idx], ai = a_im[idx];
    const float mag = expf(ar * dt);
    float sn, cs; sincosf(ai * dt, &sn, &cs);
    const float abr = mag * cs, abi = mag * sn;
    const float den = ar * ar + ai * ai, nr = abr - 1.f, ni = abi;
    const float fr = (nr * ar + ni * ai) / den, fi = (ni * ar - nr * ai) / den;
    P[S5P_AR + idx] = abr; P[S5P_AI + idx] = abi;
    for (int p = 0; p < SP; ++p) {
        const float br = b_re[idx * SP + p], bi = b_im[idx * SP + p];
        P[S5P_BR + idx * SP + p] = fr * br - fi * bi;
        P[S5P_BI + idx * SP + p] = fr * bi + fi * br;
    }
}

struct ALoadBf { const bf16* A; const float* ks; int lda; int pad; __device__ __forceinline__ float operator()(int r, int k) const { float v = bf2f(A[(size_t)r * lda + k]); return ks ? v * ks[k] : v; } };
struct BLoadPlain { const float* W; int ldw; int pad; __device__ __forceinline__ float operator()(int k, int c) const { return W[(size_t)k * ldw + c]; } };
struct BLoadInproj { const float* W; __device__ __forceinline__ float operator()(int k, int c) const {
        int oc = c; if (c < 1024) { const int cc = c & 63; oc = (c - cc) + (cc >> 1) + 32 * (cc & 1); } return W[(size_t)k * INC + oc]; } };

template <class AL, class BL, class EP>
__global__ __launch_bounds__(256) void k_gemm_naive(int Mr, int N, int K, int pad_, AL al, BL bl, EP ep) {
    __shared__ float As[16][68], Bs[16][68];
    const int tid = threadIdx.x, tx = tid & 15, ty = tid >> 4;
    const int row0 = blockIdx.y * 64, col0 = blockIdx.x * 64;
    float acc[4][4];
#pragma unroll
    for (int i = 0; i < 4; ++i)
#pragma unroll
        for (int j = 0; j < 4; ++j) acc[i][j] = 0.f;
    for (int k0 = 0; k0 < K; k0 += 16) {
#pragma unroll
        for (int i = 0; i < 4; ++i) { const int e = tid + 256 * i; const int r = e >> 4, k = e & 15; As[k][r] = al(row0 + r, k0 + k); }
#pragma unroll
        for (int i = 0; i < 4; ++i) { const int e = tid + 256 * i; const int k = e >> 6, c = e & 63; Bs[k][c] = bl(k0 + k, col0 + c); }
        __syncthreads();
#pragma unroll
        for (int k = 0; k < 16; ++k) {
            const f32x4 a = *(const f32x4*)&As[k][ty * 4]; const f32x4 b = *(const f32x4*)&Bs[k][tx * 4];
#pragma unroll
            for (int i = 0; i < 4; ++i)
#pragma unroll
                for (int j = 0; j < 4; ++j) acc[i][j] += a[i] * b[j];
        }
        __syncthreads();
    }
#pragma unroll
    for (int i = 0; i < 4; ++i) { float v[4] = {acc[i][0], acc[i][1], acc[i][2], acc[i][3]}; ep(row0 + ty * 4 + i, col0 + tx * 4, v); }
}
__device__ __forceinline__ void st4bf(bf16* p, const float* v) { uint2 o; o.x = (unsigned)f2bf(v[0]) | ((unsigned)f2bf(v[1]) << 16); o.y = (unsigned)f2bf(v[2]) | ((unsigned)f2bf(v[3]) << 16); *(uint2*)p = o; }

struct EpInproj {
    bf16 *Q, *Kb, *VU, *GR, *GS; const float2* rope;
    __device__ __forceinline__ void operator()(int r, int c, float* v) const {
        if (c < 1024) {
            const bool isk = c >= 512; const int cc = c & 511; const int i0 = (cc & 63) >> 1;
            const float2 cs0 = rope[r * 32 + i0], cs1 = rope[r * 32 + i0 + 1];
            float o[4]; o[0] = v[0] * cs0.x - v[1] * cs0.y; o[1] = v[0] * cs0.y + v[1] * cs0.x; o[2] = v[2] * cs1.x - v[3] * cs1.y; o[3] = v[2] * cs1.y + v[3] * cs1.x;
            if (isk) { o[0] *= 0.125f; o[1] *= 0.125f; o[2] *= 0.125f; o[3] *= 0.125f; }
            st4bf((isk ? Kb : Q) + (size_t)r * 512 + cc, o);
        } else if (c < 2048) st4bf(VU + (size_t)r * 2048 + (c - 1024), v);
        else if (c < 3072) { float o[4] = {siluf_(v[0]), siluf_(v[1]), siluf_(v[2]), siluf_(v[3])}; st4bf(GR + (size_t)r * 1024 + (c - 2048), o); }
        else if (c < 4096) st4bf(VU + (size_t)r * 2048 + 1024 + (c - 3072), v);
        else { float o[4] = {siluf_(v[0]), siluf_(v[1]), siluf_(v[2]), siluf_(v[3])}; st4bf(GS + (size_t)r * 1024 + (c - 4096), o); }
    }
};
struct EpGlu {
    const bf16* YG; const bf16* GS; const float* bias; bf16* VU;
    __device__ __forceinline__ void operator()(int r, int c, float* v) const {
        float o[4];
#pragma unroll
        for (int j = 0; j < 4; ++j) o[j] = bf2f(YG[(size_t)r * 1024 + c + j]) * sigmoidf_(v[j] + bias[c + j]) * bf2f(GS[(size_t)r * 1024 + c + j]);
        st4bf(VU + (size_t)r * 2048 + 1024 + c, o);
    }
};
struct EpOut {
    const float* x; float* X1; bf16* X1B;
    __device__ __forceinline__ void operator()(int r, int c, float* v) const {
        const f32x4 xv = *(const f32x4*)(x + (size_t)r * D + c);
        float o[4] = {xv.x + v[0], xv.y + v[1], xv.z + v[2], xv.w + v[3]};
        *(f32x4*)(X1 + (size_t)r * D + c) = (f32x4){o[0], o[1], o[2], o[3]};
        st4bf(X1B + (size_t)r * D + c, o);
    }
};
struct EpScaleRow {
    bf16* O; const float* rs; int ldo; float s;
    __device__ __forceinline__ void operator()(int r, int c, float* v) const {
        const float f = (rs ? rs[r] : 1.f) * s; float o[4] = {v[0] * f, v[1] * f, v[2] * f, v[3] * f}; st4bf(O + (size_t)r * ldo + c, o);
    }
};
struct EpResInplace {
    float* X;
    __device__ __forceinline__ void operator()(int r, int c, float* v) const {
        f32x4* p = (f32x4*)(X + (size_t)r * D + c); f32x4 xv = *p; xv.x += v[0]; xv.y += v[1]; xv.z += v[2]; xv.w += v[3]; *p = xv;
    }
};

__device__ __forceinline__ float ret_logg(int h) { return log1pf(-exp2f(-5.0f - (float)h)); }
__global__ __launch_bounds__(256) void k_ret_kv(const bf16* __restrict__ Kb, const bf16* __restrict__ VU, float* __restrict__ KV) {
    __shared__ bf16 Ks[128][64]; __shared__ bf16 Vs[128][128];
    const int unit = blockIdx.x, h = unit & 7, n = (unit >> 3) & 63, b = unit >> 9;
    const int t0 = b * SEQ + n * CHUNK, tid = threadIdx.x;
    for (int e = tid; e < 128 * 64; e += 256) { const int j = e >> 6, d = e & 63; Ks[j][d] = Kb[(size_t)(t0 + j) * 512 + h * 64 + d]; }
    for (int e = tid; e < 128 * 128; e += 256) { const int j = e >> 7, c = e & 127; Vs[j][c] = VU[(size_t)(t0 + j) * 2048 + h * 128 + c]; }
    __syncthreads();
    const int e = tid & 127, dh = tid >> 7; const float lg = ret_logg(h);
    float acc[32];
#pragma unroll
    for (int i = 0; i < 32; ++i) acc[i] = 0.f;
    for (int j = 0; j < 128; ++j) {
        const float vv = bf2f(Vs[j][e]) * __expf(lg * 127.0f);
#pragma unroll
        for (int i = 0; i < 32; ++i) acc[i] += bf2f(Ks[j][dh * 32 + i]) * vv;
    }
#pragma unroll
    for (int i = 0; i < 32; ++i) KV[(size_t)unit * 8192 + (dh * 32 + i) * 128 + e] = acc[i];
}
__global__ void k_ret_scan(float* __restrict__ KV) {
    const int idx = blockIdx.x * blockDim.x + threadIdx.x;
    if (idx >= BATCH * RH * 8192) return;
    const int de = idx & 8191, h = (idx >> 13) & 7, b = idx >> 16;
    const float cd = __expf(ret_logg(h) * (float)CHUNK);
    float R = 0.f;
    for (int n = 0; n < NCH; ++n) { float* p = KV + (size_t)((b * NCH + n) * RH + h) * 8192 + de; const float t = *p; *p = R; R = cd * R + t; }
}
__global__ __launch_bounds__(256) void k_ret_out(const bf16* __restrict__ Q, const bf16* __restrict__ Kb, bf16* __restrict__ VU, const bf16* __restrict__ GR,
                                                 const float* __restrict__ KV, const float* __restrict__ gn_g) {
    __shared__ bf16 Ks[128][64]; __shared__ bf16 Vs[128][128];
    const int unit = blockIdx.x, h = unit & 7, n = (unit >> 3) & 63, b = unit >> 9;
    const int t0 = b * SEQ + n * CHUNK, tid = threadIdx.x;
    for (int e = tid; e < 128 * 64; e += 256) { const int j = e >> 6, d = e & 63; Ks[j][d] = Kb[(size_t)(t0 + j) * 512 + h * 64 + d]; }
    for (int e = tid; e < 128 * 128; e += 256) { const int j = e >> 7, c = e & 127; Vs[j][c] = VU[(size_t)(t0 + j) * 2048 + h * 128 + c]; }
    __syncthreads();
    const int i = tid >> 1, eh = tid & 1; const float lg = ret_logg(h);
    float q[64], o[64];
#pragma unroll
    for (int d = 0; d < 64; ++d) q[d] = bf2f(Q[(size_t)(t0 + i) * 512 + h * 64 + d]);
#pragma unroll
    for (int e = 0; e < 64; ++e) o[e] = 0.f;
    for (int j = 0; j <= i; ++j) {
        float s = 0.f;
#pragma unroll
        for (int d = 0; d < 64; ++d) s += q[d] * bf2f(Ks[j][d]);
#pragma unroll
        for (int e = 0; e < 64; ++e) o[e] += s * bf2f(Vs[j][eh * 64 + e]);
    }
    const float qw = __expf(lg);
    const float* R = KV + (size_t)unit * 8192 + eh * 64;
#pragma unroll
    for (int d = 0; d < 64; ++d) { const float qd = q[d] * qw;
#pragma unroll
        for (int e = 0; e < 64; ++e) o[e] += qd * R[d * 128 + e]; }
    float s1 = 0.f;
#pragma unroll
    for (int e = 0; e < 64; ++e) s1 += o[e];
    s1 += __shfl_xor(s1, 1); const float mu = s1 * (1.f / 128.f);
    float s2 = 0.f;
#pragma unroll
    for (int e = 0; e < 64; ++e) { const float dlt = o[e] - mu; s2 += dlt * dlt; }
    s2 += __shfl_xor(s2, 1); const float rs = rsqrtf(s2 * (1.f / 128.f) + EPS);
    const size_t ob = (size_t)(t0 + i) * 2048 + h * 128 + eh * 64, gb = (size_t)(t0 + i) * 1024 + h * 128 + eh * 64;
#pragma unroll
    for (int e = 0; e < 64; ++e) VU[ob + e] = f2bf((o[e] - mu) * rs * gn_g[h * 128 + eh * 64 + e] * bf2f(GR[gb + e]));
}

__global__ __launch_bounds__(64) void k_s5_naive(const bf16* __restrict__ VU, const float* __restrict__ P, const float* __restrict__ c_re, const float* __restrict__ c_im,
                                                 const float* __restrict__ dvec, bf16* __restrict__ YG) {
    __shared__ float us[32][16]; __shared__ float ys[32][16];
    const int g = blockIdx.x & 63, b = blockIdx.x >> 6, lane = threadIdx.x;
    float bbr[16], bbi[16], cr[16], ci[16];
#pragma unroll
    for (int p = 0; p < 16; ++p) { bbr[p] = P[S5P_BR + (g * 64 + lane) * 16 + p]; bbi[p] = P[S5P_BI + (g * 64 + lane) * 16 + p];
        cr[p] = c_re[(g * 16 + p) * 64 + lane]; ci[p] = c_im[(g * 16 + p) * 64 + lane]; }
    const float ar = P[S5P_AR + g * 64 + lane], ai = P[S5P_AI + g * 64 + lane];
    float xr = 0.f, xi = 0.f;
    for (int l0 = 0; l0 < SEQ; l0 += 32) {
        const size_t tb = (size_t)(b * SEQ + l0);
        { const int tt = lane >> 1, hh = lane & 1; const u32x4 w = *(const u32x4*)(VU + (tb + tt) * 2048 + 1024 + g * 16 + hh * 8);
          float* d = &us[tt][hh * 8];
          d[0] = __uint_as_float(w.x << 16); d[1] = __uint_as_float(w.x & 0xffff0000u); d[2] = __uint_as_float(w.y << 16); d[3] = __uint_as_float(w.y & 0xffff0000u);
          d[4] = __uint_as_float(w.z << 16); d[5] = __uint_as_float(w.z & 0xffff0000u); d[6] = __uint_as_float(w.w << 16); d[7] = __uint_as_float(w.w & 0xffff0000u); }
        __syncthreads();
        for (int s = 0; s < 32; ++s) {
            float br = 0.f, bi = 0.f;
#pragma unroll
            for (int p = 0; p < 16; ++p) { const float uu = us[s][p]; br += bbr[p] * uu; bi += bbi[p] * uu; }
            const float nxr = ar * xr - ai * xi + br, nxi = ar * xi + ai * xr + bi; xr = nxr; xi = nxi;
            float mine = 0.f;
#pragma unroll
            for (int p = 0; p < 16; ++p) { const float tot = wave_sum(cr[p] * xr - ci[p] * xi); if (lane == p) mine = tot; }
            if (lane < 16) ys[s][lane] = mine;
        }
        __syncthreads();
#pragma unroll
        for (int k = 0; k < 8; ++k) { const int e = lane + 64 * k, s = e >> 4, p = e & 15;
            const float y = ys[s][p] + dvec[g * 16 + p] * us[s][p];
            YG[(tb + s) * 1024 + g * 16 + p] = f2bf(gelu_tanh(y)); }
        __syncthreads();
    }
}

__global__ __launch_bounds__(256) void k_rstd(const float* __restrict__ x, float* __restrict__ rs, int rows) {
    const int w = (blockIdx.x * 256 + threadIdx.x) >> 6, lane = threadIdx.x & 63;
    if (w >= rows) return;
    const f32x4* xr = (const f32x4*)(x + (size_t)w * D) + lane; float s = 0.f;
#pragma unroll
    for (int j = 0; j < 4; ++j) { const f32x4 v = xr[64 * j]; s += v.x * v.x + v.y * v.y + v.z * v.z + v.w * v.w; }
    s = wave_sum(s); if (lane == 0) rs[w] = rsqrtf(s * (1.f / D) + EPS);
}
__global__ __launch_bounds__(256) void k_final_norm(float* __restrict__ x, const float* __restrict__ g, int rows) {
    const int w = (blockIdx.x * 256 + threadIdx.x) >> 6, lane = threadIdx.x & 63;
    if (w >= rows) return;
    f32x4* xr = (f32x4*)(x + (size_t)w * D) + lane; f32x4 v[4]; float s = 0.f;
#pragma unroll
    for (int j = 0; j < 4; ++j) { v[j] = xr[64 * j]; s += v[j].x * v[j].x + v[j].y * v[j].y + v[j].z * v[j].z + v[j].w * v[j].w; }
    const float rstd = rsqrtf(wave_sum(s) * (1.f / D) + EPS);
#pragma unroll
    for (int j = 0; j < 4; ++j) { const f32x4 gv = *((const f32x4*)g + lane + 64 * j); xr[64 * j] = v[j] * rstd * gv; }
}

__global__ __launch_bounds__(256) void k_xattn_naive(const bf16* __restrict__ QA, const bf16* __restrict__ KA, const bf16* __restrict__ VA, bf16* __restrict__ OA) {
    __shared__ float ps[4][256];
    const int wv = threadIdx.x >> 6, lane = threadIdx.x & 63;
    const int item = blockIdx.x * 4 + wv;
    const int h = item & 3, t = item >> 2, b = t / SEQ;
    const bf16* q = QA + (size_t)t * 1024 + h * 256;
    float sc[4];
#pragma unroll
    for (int jj = 0; jj < 4; ++jj) {
        const bf16* kr = KA + (size_t)(b * MEM + lane + 64 * jj) * 1024 + h * 256; float s = 0.f;
        for (int d = 0; d < 256; d += 8) { const u32x4 kw = *(const u32x4*)(kr + d); const u32x4 qw = *(const u32x4*)(q + d);
            s += __uint_as_float(kw.x << 16) * __uint_as_float(qw.x << 16) + __uint_as_float(kw.x & 0xffff0000u) * __uint_as_float(qw.x & 0xffff0000u)
               + __uint_as_float(kw.y << 16) * __uint_as_float(qw.y << 16) + __uint_as_float(kw.y & 0xffff0000u) * __uint_as_float(qw.y & 0xffff0000u)
               + __uint_as_float(kw.z << 16) * __uint_as_float(qw.z << 16) + __uint_as_float(kw.z & 0xffff0000u) * __uint_as_float(qw.z & 0xffff0000u)
               + __uint_as_float(kw.w << 16) * __uint_as_float(qw.w << 16) + __uint_as_float(kw.w & 0xffff0000u) * __uint_as_float(qw.w & 0xffff0000u); }
        sc[jj] = s;
    }
    const float mx = wave_max(fmaxf(fmaxf(sc[0], sc[1]), fmaxf(sc[2], sc[3])));
    float e[4], sum = 0.f;
#pragma unroll
    for (int jj = 0; jj < 4; ++jj) { e[jj] = __expf(sc[jj] - mx); sum += e[jj]; }
    sum = wave_sum(sum); const float inv = 1.f / sum;
#pragma unroll
    for (int jj = 0; jj < 4; ++jj) ps[wv][lane + 64 * jj] = e[jj] * inv;
    __syncthreads();
    float o[4] = {0.f, 0.f, 0.f, 0.f};
    for (int j = 0; j < 256; ++j) {
        const float p = ps[wv][j]; const uint2 vw = *(const uint2*)(VA + (size_t)(b * MEM + j) * 1024 + h * 256 + lane * 4);
        o[0] += p * __uint_as_float(vw.x << 16); o[1] += p * __uint_as_float(vw.x & 0xffff0000u); o[2] += p * __uint_as_float(vw.y << 16); o[3] += p * __uint_as_float(vw.y & 0xffff0000u);
    }
    st4bf(OA + (size_t)t * 1024 + h * 256 + lane * 4, o);
}

namespace pg8 {
#define PG8_LAS __attribute__((address_space(3)))
typedef unsigned short bf16_t;
typedef short bf16x8 __attribute__((ext_vector_type(8)));
typedef float f32x4 __attribute__((ext_vector_type(4)));
typedef unsigned u32x4 __attribute__((ext_vector_type(4)));
constexpr int BM = 256, BK = 64, HALF = 128, HTB = HALF * BK * 2  , STAGE_BYTES = 8 * HTB, NXCD = 8, WGM = 8;

__host__ __device__ __forceinline__ int lds_byte(int r, int c) { const int st = (r >> 4) * 2 + (c >> 5), rr = r & 15, cc = c & 31, ob = rr * 64 + cc * 2; return st * 1024 + (ob ^ (((ob >> 9) & 1) << 5)); }
__host__ __device__ __forceinline__ void stage_rc(int b, int& R, int& C) { const int st = b / 1024, sb = b % 1024, swz = sb ^ (((sb >> 9) & 1) << 5); R = (st >> 1) * 16 + swz / 64; C = (st & 1) * 32 + (swz % 64) / 2; }
__host__ __device__ __forceinline__ int perm32(int rho) { const int n = rho >> 4, i = rho & 15; return 8 * (i >> 2) + 4 * n + (i & 3); }

struct Unit { int pm, pn; };
struct Gemm { const bf16_t* A; const bf16_t* Bt; int M, N, K; };

struct StaticOrder {
    int nM, nN, nwg, G, c;
    __host__ __device__ void init(int M, int N, int G_, int c_) { nM = M / BM; nN = N / BM; nwg = nM * nN; G = G_; c = c_; }
    __host__ __device__ bool next(int i, Unit& u) const {
        const long L = (long)i * G + c; if (L >= nwg) return false;
        int wgid = (int)L; { const int q = nwg / NXCD, r = nwg % NXCD, xcd = wgid % NXCD, off = wgid / NXCD; wgid = (xcd < r ? xcd * (q + 1) : r * (q + 1) + (xcd - r) * q) + off; }
        const int nig = WGM * nN, gid = wgid / nig, fm = gid * WGM, gsz = (nM - fm) < WGM ? (nM - fm) : WGM;
        u.pm = fm + ((wgid % nig) % gsz); u.pn = (wgid % nig) / gsz; return true;
    }
    __device__ __forceinline__ void a_ready(const Unit&) const {}
    __device__ __forceinline__ void done(const Unit&) const {}
};


template <class Epi, class Sched, bool ALIGN_EPI = false, bool SP2 = false>
__device__ __forceinline__ void gemm_phase(PG8_LAS unsigned char* lds, const Gemm g, const Sched& S, const Epi& E) {
    const int tid = threadIdx.x, wid = __builtin_amdgcn_readfirstlane(tid >> 6), lane = tid & 63, wr = wid >> 2, wc = wid & 3, fr = lane & 15, fq = lane >> 4;
    const int K = g.K, nt = K / BK;
    unsigned voffA[2], voffB[2];
#pragma unroll
    for (int i = 0; i < 2; ++i) { int R, C; stage_rc(tid * 16 + i * 8192, R, C); const int Rb = Epi::PERM ? ((R & ~31) + perm32(R & 31)) : R;
        voffA[i] = (unsigned)(R * K + C) * 2u; voffB[i] = (unsigned)(Rb * K + C) * 2u; }
    const size_t kstep = (size_t)(BK * 2);
    const size_t hstep = (size_t)HALF * K * 2;
    const size_t tstep = 2 * hstep;
    const unsigned ldsw = (unsigned)wid * 1024u;
    const int aoff = lds_byte(wr * 64 + fr, fq * 8), boff = lds_byte(wc * 32 + fr, fq * 8);
#define PG8_SA(b, h) (((b) * 2 + (h)) * HTB)
#define PG8_SB(b, h) ((4 + (b) * 2 + (h)) * HTB)
#define PG8_STAGE(bufoff, gbase, voff) do { _Pragma("unroll") for (int _i = 0; _i < 2; ++_i) \
        __builtin_amdgcn_global_load_lds((const unsigned*)((const char*)(gbase) + (voff)[_i]), (PG8_LAS unsigned*)(lds + (bufoff) + ldsw + _i * 8192), 16, 0, 0); } while (0)
#define PG8_LDA(dst, b, h) do { _Pragma("unroll") for (int m = 0; m < 4; ++m) _Pragma("unroll") for (int k = 0; k < 2; ++k) dst[m][k] = *(const PG8_LAS bf16x8*)(lds + PG8_SA(b, h) + aoff + m * 2048 + k * 1024); } while (0)
#define PG8_LDB(dst, b, h) do { _Pragma("unroll") for (int n = 0; n < 2; ++n) _Pragma("unroll") for (int k = 0; k < 2; ++k) dst[n][k] = *(const PG8_LAS bf16x8*)(lds + PG8_SB(b, h) + boff + n * 2048 + k * 1024); } while (0)
#define PG8_MMA(ai, bj, At, Bt) do { __builtin_amdgcn_s_setprio(1); _Pragma("unroll") for (int m = 0; m < 4; ++m) _Pragma("unroll") for (int n = 0; n < 2; ++n) _Pragma("unroll") for (int k = 0; k < 2; ++k) \
        acc[ai][bj][m][n] = __builtin_amdgcn_mfma_f32_16x16x32_bf16(Bt[n][k], At[m][k], acc[ai][bj][m][n], 0, 0, 0); __builtin_amdgcn_s_setprio(0); } while (0)
#define PG8_WAIT_V(n) asm volatile("s_waitcnt vmcnt(" #n ")" ::: "memory")
#define PG8_WAIT_L(n) asm volatile("s_waitcnt lgkmcnt(" #n ")" ::: "memory")
#define PG8_BAR __builtin_amdgcn_s_barrier()
#define PG8_SCHED __builtin_amdgcn_sched_barrier(0)
    Unit cur, nxt; int ui = 0;
    if (!S.next(0, cur)) return;
    f32x4 acc[2][2][4][2];
#pragma unroll
    for (int a = 0; a < 2; ++a)
#pragma unroll
        for (int b = 0; b < 2; ++b)
#pragma unroll
            for (int m = 0; m < 4; ++m)
#pragma unroll
                for (int n = 0; n < 2; ++n) acc[a][b][m][n] = (f32x4){0.f, 0.f, 0.f, 0.f};
    bf16x8 At[4][2], B0[2][2], B1[2][2];
    const char* cA = (const char*)g.A + (size_t)cur.pm * tstep; const char* cB = (const char*)g.Bt + (size_t)cur.pn * tstep;
    S.a_ready(cur);
    if constexpr (SP2) {
        PG8_STAGE(PG8_SB(0, 0), cB, voffB); PG8_STAGE(PG8_SB(0, 1), cB + hstep, voffB); PG8_STAGE(PG8_SA(0, 0), cA, voffA); PG8_STAGE(PG8_SA(0, 1), cA + hstep, voffA);
        if (wr == 1) PG8_BAR;
        PG8_WAIT_V(2); PG8_BAR;
        PG8_STAGE(PG8_SB(1, 0), cB + kstep, voffB); PG8_STAGE(PG8_SA(1, 0), cA + kstep, voffA); PG8_STAGE(PG8_SB(1, 1), cB + hstep + kstep, voffB);
        PG8_WAIT_V(6); PG8_BAR;
    } else {
        PG8_STAGE(PG8_SB(0, 0), cB, voffB); PG8_STAGE(PG8_SA(0, 0), cA, voffA); PG8_STAGE(PG8_SB(0, 1), cB + hstep, voffB); PG8_STAGE(PG8_SA(0, 1), cA + hstep, voffA);
        if (wr == 1) PG8_BAR;
        PG8_WAIT_V(4); PG8_BAR;
        PG8_STAGE(PG8_SB(1, 0), cB + kstep, voffB); PG8_STAGE(PG8_SA(1, 0), cA + kstep, voffA); PG8_STAGE(PG8_SB(1, 1), cB + hstep + kstep, voffB);
        PG8_WAIT_V(6); PG8_BAR;
    }
    for (;;) {
        const bool has_next = S.next(ui + 1, nxt);
        const char* nA = has_next ? (const char*)g.A + (size_t)nxt.pm * tstep : cA; const char* nB = has_next ? (const char*)g.Bt + (size_t)nxt.pn * tstep : cB;
        for (int t = 0; t < nt; t += 2) {
            const bool last = (t == nt - 2);
            const char* a1 = cA + (size_t)(t + 1) * kstep;
            const char* a2 = last ? nA : cA + (size_t)(t + 2) * kstep; const char* b2 = last ? nB : cB + (size_t)(t + 2) * kstep;
            const char* a3 = a2 + kstep; const char* b3 = b2 + kstep;
            if (last && has_next) S.a_ready(nxt);
            if constexpr (SP2) {
            PG8_LDB(B0, 0, 0); PG8_LDB(B1, 0, 1); PG8_SCHED; PG8_LDA(At, 0, 0); PG8_STAGE(PG8_SA(1, 1), a1 + hstep, voffA);
            PG8_WAIT_V(8); PG8_WAIT_L(0); PG8_BAR; PG8_MMA(0, 0, At, B0); PG8_MMA(0, 1, At, B1); PG8_BAR; PG8_SCHED;
            PG8_LDA(At, 0, 1); PG8_STAGE(PG8_SB(0, 0), b2, voffB); PG8_STAGE(PG8_SB(0, 1), b2 + hstep, voffB); PG8_STAGE(PG8_SA(0, 0), a2, voffA);
            PG8_WAIT_V(8); PG8_WAIT_L(0); PG8_BAR; PG8_MMA(1, 0, At, B0); PG8_MMA(1, 1, At, B1); PG8_BAR; PG8_SCHED;
            PG8_LDB(B0, 1, 0); PG8_LDB(B1, 1, 1); PG8_SCHED; PG8_LDA(At, 1, 0); PG8_STAGE(PG8_SA(0, 1), a2 + hstep, voffA);
            PG8_WAIT_V(8); PG8_WAIT_L(0); PG8_BAR; PG8_MMA(0, 0, At, B0); PG8_MMA(0, 1, At, B1); PG8_BAR; PG8_SCHED;
            PG8_LDA(At, 1, 1); PG8_STAGE(PG8_SB(1, 0), b3, voffB); PG8_STAGE(PG8_SB(1, 1), b3 + hstep, voffB); PG8_STAGE(PG8_SA(1, 0), a3, voffA);
            PG8_WAIT_V(8); PG8_WAIT_L(0); PG8_BAR; PG8_MMA(1, 0, At, B0); PG8_MMA(1, 1, At, B1); PG8_BAR; PG8_SCHED;
            } else {
            PG8_LDB(B0, 0, 0); PG8_SCHED; PG8_LDA(At, 0, 0); PG8_STAGE(PG8_SA(1, 1), a1 + hstep, voffA);
            PG8_WAIT_L(8); PG8_BAR; PG8_WAIT_L(0); PG8_MMA(0, 0, At, B0); PG8_BAR; PG8_SCHED;
            PG8_LDB(B1, 0, 1); PG8_STAGE(PG8_SB(0, 0), b2, voffB);
            PG8_BAR; PG8_WAIT_L(0); PG8_MMA(0, 1, At, B1); PG8_BAR;
            PG8_LDA(At, 0, 1); PG8_STAGE(PG8_SA(0, 0), a2, voffA);
            PG8_BAR; PG8_WAIT_L(0); PG8_MMA(1, 0, At, B0); PG8_BAR; PG8_SCHED;
            PG8_STAGE(PG8_SB(0, 1), b2 + hstep, voffB);
            PG8_WAIT_V(6); PG8_BAR; PG8_MMA(1, 1, At, B1); PG8_BAR;
            PG8_LDB(B0, 1, 0); PG8_SCHED; PG8_LDA(At, 1, 0); PG8_STAGE(PG8_SA(0, 1), a2 + hstep, voffA);
            PG8_WAIT_L(8); PG8_BAR; PG8_WAIT_L(0); PG8_MMA(0, 0, At, B0); PG8_BAR; PG8_SCHED;
            PG8_LDB(B1, 1, 1); PG8_STAGE(PG8_SB(1, 0), b3, voffB);
            PG8_BAR; PG8_WAIT_L(0); PG8_MMA(0, 1, At, B1); PG8_BAR;
            PG8_LDA(At, 1, 1); PG8_STAGE(PG8_SA(1, 0), a3, voffA);
            PG8_BAR; PG8_WAIT_L(0); PG8_MMA(1, 0, At, B0); PG8_BAR; PG8_SCHED;
            PG8_STAGE(PG8_SB(1, 1), b3 + hstep, voffB);
            PG8_WAIT_V(6); PG8_BAR; PG8_MMA(1, 1, At, B1); PG8_BAR;
            }
        }
        if constexpr (ALIGN_EPI) { if (wr == 0) PG8_BAR; }
        if constexpr (!Epi::AFTER_DRAIN) { E(acc, cur, wr, wc, fr, fq); S.done(cur); }
        if (!has_next) break;
#pragma unroll
        for (int a = 0; a < 2; ++a)
#pragma unroll
            for (int b = 0; b < 2; ++b)
#pragma unroll
                for (int m = 0; m < 4; ++m)
#pragma unroll
                    for (int n = 0; n < 2; ++n) acc[a][b][m][n] = (f32x4){0.f, 0.f, 0.f, 0.f};
        cur = nxt; cA = nA; cB = nB; ++ui;
        if constexpr (ALIGN_EPI) { if (wr == 1) PG8_BAR; }
    }
    PG8_WAIT_V(0);
    if constexpr (!ALIGN_EPI) { if (wr == 0) PG8_BAR; }
    PG8_BAR;
    if constexpr (Epi::AFTER_DRAIN) { E.fused(acc, cur, wr, wc, fr, fq, lds, wid, lane); S.done(cur); }
#undef PG8_SA
#undef PG8_SB
#undef PG8_STAGE
#undef PG8_LDA
#undef PG8_LDB
#undef PG8_MMA
#undef PG8_WAIT_V
#undef PG8_WAIT_L
#undef PG8_BAR
#undef PG8_SCHED
}
}

namespace pg8 {
__device__ __forceinline__ unsigned cvt_pk_bf16(float lo, float hi) { return cvtpk_s(lo, hi); }
__device__ __forceinline__ float fast_sigmoid(float x) { return __builtin_amdgcn_rcpf(1.f + __builtin_amdgcn_exp2f(-1.4426950408889634f * x)); }
__device__ __forceinline__ u32x4 pack8(const f32x4 v0, const f32x4 v1) { u32x4 w; w.x = cvt_pk_bf16(v0[0], v0[1]); w.y = cvt_pk_bf16(v0[2], v0[3]); w.z = cvt_pk_bf16(v1[0], v1[1]); w.w = cvt_pk_bf16(v1[2], v1[3]); return w; }
struct EpInprojMK {
    static constexpr bool PERM = true, AFTER_DRAIN = false;
    bf16_t *Q, *Kb, *VU, *GR, *GS; const float* rope;
    __device__ __forceinline__ void operator()(const f32x4 (&acc)[2][2][4][2], const Unit& u, int wr, int wc, int fr, int fq) const {
        const int row0 = u.pm * BM + wr * 64 + fr, colw = wc * 32 + 8 * fq, pn = u.pn;
        if (pn < 4) {
            bf16_t* base = (pn < 2 ? Q : Kb) + (pn & 1) * 256;
#pragma unroll
            for (int ai = 0; ai < 2; ++ai)
#pragma unroll
                for (int m = 0; m < 4; ++m) { const int r = row0 + ai * HALF + m * 16;
                    float dsc[2];
#pragma unroll
                    for (int bj = 0; bj < 2; ++bj) { const float lg2 = __log2f(1.0f - __builtin_amdgcn_exp2f(-5.0f - (float)((pn & 1) * 4 + 2 * bj + (wc >> 1))));
                        dsc[bj] = __builtin_amdgcn_exp2f((pn < 2 ? lg2 : -lg2) * (float)(r & 127)); }
#pragma unroll
                    for (int bj = 0; bj < 2; ++bj) { const int c = colw + bj * HALF; const float* rp = rope + (size_t)r * 64 + (c & 63);
                        const f32x4 t0 = *(const f32x4*)rp, t1 = *(const f32x4*)(rp + 4);
                        const f32x4 v0 = acc[ai][bj][m][0], v1 = acc[ai][bj][m][1];
                        f32x4 o0, o1;
                        o0[0] = v0[0] * t0[0] - v0[1] * t0[1]; o0[1] = v0[0] * t0[1] + v0[1] * t0[0]; o0[2] = v0[2] * t0[2] - v0[3] * t0[3]; o0[3] = v0[2] * t0[3] + v0[3] * t0[2];
                        o1[0] = v1[0] * t1[0] - v1[1] * t1[1]; o1[1] = v1[0] * t1[1] + v1[1] * t1[0]; o1[2] = v1[2] * t1[2] - v1[3] * t1[3]; o1[3] = v1[2] * t1[3] + v1[3] * t1[2];
                        o0 = o0 * dsc[bj] ; o1 = o1 * dsc[bj];
                        *(u32x4*)(base + (size_t)r * 512 + c) = pack8(o0, o1); } }
        } else {
            const bool act = (pn >= 8 && pn < 12) || pn >= 16;
            bf16_t* base; int ld;
            if (pn < 8) { base = VU + (pn - 4) * 256; ld = 2048; } else if (pn < 12) { base = GR + (pn - 8) * 256; ld = 1024; }
            else if (pn < 16) { base = VU + 1024 + (pn - 12) * 256; ld = 2048; } else { base = GS + (pn - 16) * 256; ld = 1024; }
#pragma unroll
            for (int ai = 0; ai < 2; ++ai)
#pragma unroll
                for (int m = 0; m < 4; ++m) { bf16_t* rowp = base + (size_t)(row0 + ai * HALF + m * 16) * ld + colw;
#pragma unroll
                    for (int bj = 0; bj < 2; ++bj) { f32x4 v0 = acc[ai][bj][m][0], v1 = acc[ai][bj][m][1];
                        if (act) {
#pragma unroll
                            for (int e = 0; e < 4; ++e) { v0[e] = v0[e] * fast_sigmoid(v0[e]); v1[e] = v1[e] * fast_sigmoid(v1[e]); } }
                        *(u32x4*)(rowp + bj * HALF) = pack8(v0, v1); } }
        }
    }
};

struct EpBf16Split {
    static constexpr bool PERM = true, AFTER_DRAIN = false;
    bf16_t* O; int ldc; int split_cols; size_t split_stride;
    __device__ __forceinline__ void operator()(const f32x4 (&acc)[2][2][4][2], const Unit& u, int wr, int wc, int fr, int fq) const {
        const int row0 = u.pm * BM + wr * 64 + fr; int colt = u.pn * BM; bf16_t* base = O;
        if (split_cols) { const int t = colt / split_cols; base += (size_t)t * split_stride; colt -= t * split_cols; }
        const int col0 = colt + wc * 32 + 8 * fq;
#pragma unroll
        for (int ai = 0; ai < 2; ++ai)
#pragma unroll
            for (int m = 0; m < 4; ++m) { bf16_t* rowp = base + (size_t)(row0 + ai * HALF + m * 16) * ldc + col0;
#pragma unroll
                for (int bj = 0; bj < 2; ++bj) *(u32x4*)(rowp + bj * HALF) = pack8(acc[ai][bj][m][0], acc[ai][bj][m][1]); }
    }
};
__device__ __forceinline__ f32x4 bf4lo(unsigned a, unsigned b) { return (f32x4){__uint_as_float(a << 16), __uint_as_float(a & 0xffff0000u), __uint_as_float(b << 16), __uint_as_float(b & 0xffff0000u)}; }
struct EpGluMK {
    static constexpr bool PERM = true, AFTER_DRAIN = false;
    const bf16_t* YG; const bf16_t* GS; const float* bias; bf16_t* VU;
    __device__ __forceinline__ void operator()(const f32x4 (&acc)[2][2][4][2], const Unit& u, int wr, int wc, int fr, int fq) const {
        const int row0 = u.pm * BM + wr * 64 + fr, col0 = u.pn * BM + wc * 32 + 8 * fq;
        f32x4 bv[2][2];
#pragma unroll
        for (int bj = 0; bj < 2; ++bj) { bv[bj][0] = *(const f32x4*)(bias + col0 + bj * HALF); bv[bj][1] = *(const f32x4*)(bias + col0 + bj * HALF + 4); }
#pragma unroll
        for (int ai = 0; ai < 2; ++ai)
#pragma unroll
            for (int m = 0; m < 4; ++m) { const size_t r = (size_t)(row0 + ai * HALF + m * 16);
#pragma unroll
                for (int bj = 0; bj < 2; ++bj) { const int c = col0 + bj * HALF;
                    const u32x4 yw = *(const u32x4*)(YG + r * 1024 + c), gw = *(const u32x4*)(GS + r * 1024 + c);
                    const f32x4 y0 = bf4lo(yw.x, yw.y), y1 = bf4lo(yw.z, yw.w), g0 = bf4lo(gw.x, gw.y), g1 = bf4lo(gw.z, gw.w);
                    f32x4 z0 = acc[ai][bj][m][0] + bv[bj][0], z1 = acc[ai][bj][m][1] + bv[bj][1], o0, o1;
#pragma unroll
                    for (int e = 0; e < 4; ++e) { o0[e] = y0[e] * fast_sigmoid(z0[e]) * g0[e]; o1[e] = y1[e] * fast_sigmoid(z1[e]) * g1[e]; }
                    *(u32x4*)(VU + r * 2048 + 1024 + c) = pack8(o0, o1); } }
    }
};
struct EpResMK {
    static constexpr bool PERM = true, AFTER_DRAIN = false;
    const float* base; float* X1; bf16_t* X1B; float* SSQ;
    __device__ __forceinline__ void operator()(const f32x4 (&acc)[2][2][4][2], const Unit& u, int wr, int wc, int fr, int fq) const {
        const int row0 = u.pm * BM + wr * 64 + fr, col0 = u.pn * BM + wc * 32 + 8 * fq;
#pragma unroll
        for (int ai = 0; ai < 2; ++ai)
#pragma unroll
            for (int m = 0; m < 4; ++m) { const size_t r = (size_t)(row0 + ai * HALF + m * 16); float ss = 0.f;
#pragma unroll
                for (int bj = 0; bj < 2; ++bj) { const int c = col0 + bj * HALF;
                    const f32x4 o0 = *(const f32x4*)(base + r * 1024 + c) + acc[ai][bj][m][0], o1 = *(const f32x4*)(base + r * 1024 + c + 4) + acc[ai][bj][m][1];
                    *(f32x4*)(X1 + r * 1024 + c) = o0; *(f32x4*)(X1 + r * 1024 + c + 4) = o1;
                    if (X1B) *(u32x4*)(X1B + r * 1024 + c) = pack8(o0, o1);
                    ss += (o0[0] * o0[0] + o0[1] * o0[1]) + (o0[2] * o0[2] + o0[3] * o0[3]) + (o1[0] * o1[0] + o1[1] * o1[1]) + (o1[2] * o1[2] + o1[3] * o1[3]); }
                ss += __shfl_xor(ss, 16); ss += __shfl_xor(ss, 32);
                if (fq == 0) SSQ[r * 16 + u.pn * 4 + wc] = ss; }
    }
};
struct EpQMK {
    static constexpr bool PERM = true, AFTER_DRAIN = false;
    bf16_t* QA; const float* SSQ;
    __device__ __forceinline__ void operator()(const f32x4 (&acc)[2][2][4][2], const Unit& u, int wr, int wc, int fr, int fq) const {
        const int row0 = u.pm * BM + wr * 64 + fr, col0 = u.pn * BM + wc * 32 + 8 * fq;
#pragma unroll
        for (int ai = 0; ai < 2; ++ai)
#pragma unroll
            for (int m = 0; m < 4; ++m) { const size_t r = (size_t)(row0 + ai * HALF + m * 16);
                const f32x4 s0 = *(const f32x4*)(SSQ + r * 16), s1 = *(const f32x4*)(SSQ + r * 16 + 4), s2 = *(const f32x4*)(SSQ + r * 16 + 8), s3 = *(const f32x4*)(SSQ + r * 16 + 12);
                const f32x4 st = (s0 + s1) + (s2 + s3); const float rs = rsqrtf(((st[0] + st[1]) + (st[2] + st[3])) * (1.f / 1024.f) + 1e-6f);
#pragma unroll
                for (int bj = 0; bj < 2; ++bj) *(u32x4*)(QA + r * 1024 + col0 + bj * HALF) = pack8(acc[ai][bj][m][0] * rs, acc[ai][bj][m][1] * rs); }
    }
};
}

constexpr int NWAVES = 8;
constexpr int RING_OFF = 0, RING_BYTES = 131072;
constexpr int LDSCTL_OFF = RING_BYTES, MISC_OFF = LDSCTL_OFF + 320;
constexpr int LDS_BYTES = 147456;
constexpr size_t WS_WIN = 8 * MiB, WS_WGLU = 18 * MiB, WS_WOUT = 20 * MiB, WS_WQ = 24 * MiB, WS_WKV = 26 * MiB, WS_WO = 30 * MiB;
constexpr size_t CTL_ZERO_BYTES = 256 * 1024;
constexpr int CW_TMO = 0, CW_BAR = 4096;

#define GAS __attribute__((address_space(1)))
#define LAS __attribute__((address_space(3)))
typedef unsigned v4u __attribute__((ext_vector_type(4)));
typedef short bf16x8 __attribute__((ext_vector_type(8)));
typedef GAS unsigned gu32;
#define RLX_AGENT __ATOMIC_RELAXED, __HIP_MEMORY_SCOPE_AGENT
#define LDS_WAIT() asm volatile("s_waitcnt lgkmcnt(0)" ::: "memory")
#define VM_WAIT() asm volatile("s_waitcnt vmcnt(0)" ::: "memory")
__device__ __forceinline__ unsigned pk2(float lo, float hi) { return (unsigned)f2bf(lo) | ((unsigned)f2bf(hi) << 16); }

#define XB_TMO      128
#define XB_XCNT(j)  (256  + 64 * (j))
#define XB_XSUB(j)  (1280 + 64 * (j))
#define XB_XGEN(j)  (2304 + 64 * (j))
#define XB_TOP      3328
#define XB_TOPGEN   3392
#define XCD_BAR_WORDS 3456
#define XB_SPIN_CAP (1u << 18)

__device__ __forceinline__ unsigned xb_ld(unsigned* p)              { return __hip_atomic_load(p, __ATOMIC_RELAXED, __HIP_MEMORY_SCOPE_AGENT); }
__device__ __forceinline__ unsigned xb_add(unsigned* p, unsigned v) { return __hip_atomic_fetch_add(p, v, __ATOMIC_RELAXED, __HIP_MEMORY_SCOPE_AGENT); }
__device__ __forceinline__ unsigned xb_xcc_id() { return (unsigned)__builtin_amdgcn_s_getreg((3 << 11) | 20) & 0xFu; }
#define XB_SPIN(cond, bar) do { unsigned _sp = 0; while (cond) { __builtin_amdgcn_s_sleep(1); \
    if ((++_sp & 255u) == 0u) { if (xb_ld(&(bar)[XB_TMO])) break; if (_sp > XB_SPIN_CAP) { atomicAdd(&(bar)[XB_TMO], 1u); break; } } } } while (0)

struct XcdBarrier {
    unsigned* bar; unsigned x;
    volatile LAS unsigned* st;
};

__device__ __forceinline__ XcdBarrier xcd_barrier_post(unsigned* bar, volatile LAS unsigned* st) {
    XcdBarrier b; b.bar = bar; b.x = xb_xcc_id(); b.st = st;
    if (threadIdx.x == 0) (void)xb_add(&bar[XB_XCNT(b.x)], 1u);
    return b;
}
__device__ __forceinline__ void xcd_barrier_complete(unsigned* bar, unsigned x, unsigned& nloc, unsigned& nx) {
    const unsigned G = gridDim.x * gridDim.y * gridDim.z;
    unsigned sum, cnt, mine, sp = 0u;
    for (;;) {
        sum = 0u; cnt = 0u; mine = 0u;
#pragma unroll
        for (unsigned j = 0; j < 16; ++j) { const unsigned c = xb_ld(&bar[XB_XCNT(j)]); sum += c; cnt += (c > 0u) ? 1u : 0u; mine = (j == x) ? c : mine; }
        if (sum == G) break;
        __builtin_amdgcn_s_sleep(1);
        if ((++sp & 255u) == 0u) { if (xb_ld(&bar[XB_TMO])) break; if (sp > XB_SPIN_CAP) { atomicAdd(&bar[XB_TMO], 1u); break; } }
    }
    nloc = mine > 0u ? mine : 1u; nx = cnt > 0u ? cnt : 1u;
}

__device__ __forceinline__ void xcd_barrier(const XcdBarrier& b) {
    asm volatile("s_waitcnt vmcnt(0)" ::: "memory");
    __syncthreads();
    if (threadIdx.x == 0) {
        unsigned* bar = b.bar;
        __builtin_amdgcn_s_waitcnt(0);
        unsigned nloc = b.st[0], nx = b.st[1];
        if (nloc == 0u) { xcd_barrier_complete(bar, b.x, nloc, nx); b.st[0] = nloc; b.st[1] = nx; }
        const unsigned old = xb_add(&bar[XB_XSUB(b.x)], 1u);
        const unsigned gen = old / nloc;
        if (old + 1u == (gen + 1u) * nloc) {
            __builtin_amdgcn_fence(__ATOMIC_RELEASE, "agent");
            asm volatile("s_waitcnt vmcnt(0)" ::: "memory");
            const unsigned og = xb_add(&bar[XB_TOP], 1u);
            const unsigned tg = og / nx;
            if (og + 1u == (tg + 1u) * nx) xb_add(&bar[XB_TOPGEN], 1u);
            else XB_SPIN(xb_ld(&bar[XB_TOPGEN]) == tg, bar);
            __builtin_amdgcn_fence(__ATOMIC_ACQUIRE, "agent");
            xb_add(&bar[XB_XGEN(b.x)], 1u);
            asm volatile("s_waitcnt vmcnt(0)" ::: "memory");
        } else {
            XB_SPIN(xb_ld(&bar[XB_XGEN(b.x)]) == gen, bar);
            __builtin_amdgcn_fence(__ATOMIC_ACQUIRE, "agent");
            asm volatile("s_waitcnt vmcnt(0)" ::: "memory");
        }
    }
    __syncthreads();
}


struct Frame {
    LAS unsigned char* lds;
    volatile LAS unsigned* MISC;
    gu32* ctl;
    int tid, lane, wave;
    int vcu, G;
};
struct Args { const void* in[24]; float* out; unsigned char* ws; int ph_lo, ph_hi, li, pad; };

template <int KIND>
__device__ __forceinline__ void p0_transpose_item(const float* __restrict__ W, int K, int N, bf16* WT, int row_off, const float* __restrict__ ks, LAS float* scr, int item, int lane) {
    const int nblk = N / 32, kb = item / nblk, nb = item % nblk, k0 = 64 * kb, n0 = 32 * nb;
    const int np = n0 + (lane & 31); int oc = np; float cs = 1.f;
    if (KIND == 1) { if (np < 1024) { const int cc = np & 63; oc = (np - cc) + (cc >> 1) + 32 * (cc & 1); if (np >= 512) cs = 0.125f; } }
    if (KIND == 2) cs = 0.0625f;
#pragma unroll 8
    for (int i = 0; i < 32; ++i) { const int kk = 2 * i + (lane >> 5); float w = W[(size_t)(k0 + kk) * N + oc]; if (ks) w *= ks[k0 + kk]; scr[kk * 33 + (lane & 31)] = w * cs; }
    LDS_WAIT(); asm volatile("" ::: "memory");
    const int c = lane & 7;
#pragma unroll
    for (int j = 0; j < 4; ++j) { const int n = (lane >> 3) + 8 * j; const LAS float* s = scr + (8 * c) * 33 + n;
        v4u o; o.x = pk2(s[0 * 33], s[1 * 33]); o.y = pk2(s[2 * 33], s[3 * 33]); o.z = pk2(s[4 * 33], s[5 * 33]); o.w = pk2(s[6 * 33], s[7 * 33]);
        *(GAS v4u*)(WT + (size_t)(row_off + n0 + n) * K + k0 + 8 * c) = o; }
    LDS_WAIT(); asm volatile("" ::: "memory");
}
__device__ __forceinline__ void rms_row_to_bf16(const float* xrow, bf16* orow, int lane) {
    const GAS f32x4* xr = (const GAS f32x4*)xrow + lane;
    f32x4 v[4]; float s = 0.f;
#pragma unroll
    for (int j = 0; j < 4; ++j) { v[j] = xr[64 * j]; s += (v[j].x * v[j].x + v[j].y * v[j].y) + (v[j].z * v[j].z + v[j].w * v[j].w); }
    const float rstd = rsqrtf(wave_sum(s) * (1.f / D) + EPS);
    GAS unsigned long long* o8 = (GAS unsigned long long*)orow + lane;
#pragma unroll
    for (int j = 0; j < 4; ++j) o8[64 * j] = (unsigned long long)pk2(v[j].x * rstd, v[j].y * rstd) | ((unsigned long long)pk2(v[j].z * rstd, v[j].w * rstd) << 32);
}


namespace xatt {
typedef float f32x16 __attribute__((ext_vector_type(16)));
typedef short s16x4 __attribute__((ext_vector_type(4)));
typedef short v4i16_t __attribute__((ext_vector_type(4)));
typedef short bf16x8 __attribute__((ext_vector_type(8)));
typedef unsigned u32x4 __attribute__((ext_vector_type(4)));
__device__ __forceinline__ s16x4 vtr(const LAS unsigned char* p) { return __builtin_bit_cast(s16x4, __builtin_amdgcn_ds_read_tr16_b64_v4i16((LAS v4i16_t*)p)); }
__device__ __forceinline__ unsigned cvtpk(float lo, float hi) { return cvtpk_s(lo, hi); }
__device__ __forceinline__ void attn_unit(LAS unsigned char* lds, const bf16* __restrict__ QA, const bf16* __restrict__ KA, const bf16* __restrict__ VA, bf16* __restrict__ OA, int b, int h, int qb) {
    const int tid = threadIdx.x, lane = tid & 63, r = lane & 31, hh = lane >> 5; const int wid = __builtin_amdgcn_readfirstlane(tid >> 6);
    const char* Kh = (const char*)(KA + (size_t)(b * MEM) * 1024 + h * 256);
    const char* Vh = (const char*)(VA + (size_t)(b * MEM) * 1024 + h * 256);
#pragma unroll
    for (int i = 0; i < 16; ++i) { const int blk = wid * 16 + i, row = 2 * blk + hh;
        __builtin_amdgcn_global_load_lds((const unsigned*)(Kh + (size_t)row * 2048 + ((r ^ (row & 15)) << 4)), (LAS unsigned*)(lds + blk * 1024), 16, 0, 0); }
    const size_t t0 = (size_t)b * SEQ + (size_t)qb * 256 + wid * 32;
    const bf16* qrow = QA + (t0 + r) * 1024 + h * 256 + hh * 8;
    bf16x8 qc = *(const bf16x8*)qrow, qn = qc;
    __syncthreads();
    f32x16 acc[8];
#pragma unroll
    for (int kb = 0; kb < 8; ++kb) {
#pragma unroll
        for (int e = 0; e < 16; ++e) acc[kb][e] = 0.f;
    }
#pragma unroll 1
    for (int s = 0; s < 16; ++s) {
        if (s + 1 < 16) qn = *(const bf16x8*)(qrow + 16 * (s + 1));
        const LAS unsigned char* kp = lds + r * 512 + (((2 * s + hh) ^ (r & 15)) << 4);
#pragma unroll
        for (int kb = 0; kb < 8; ++kb) { const bf16x8 kf = *(const LAS bf16x8*)(kp + kb * 16384);
            acc[kb] = __builtin_amdgcn_mfma_f32_32x32x16_bf16(kf, qc, acc[kb], 0, 0, 0); }
        qc = qn;
    }
    __syncthreads();
#pragma unroll
    for (int i = 0; i < 16; ++i) { const int blk = wid * 16 + i, row = 2 * blk + hh;
        __builtin_amdgcn_global_load_lds((const unsigned*)(Vh + (size_t)row * 2048 + ((r ^ ((row & 3) << 2)) << 4)), (LAS unsigned*)(lds + blk * 1024), 16, 0, 0); }
    float mx = acc[0][0];
#pragma unroll
    for (int kb = 0; kb < 8; ++kb)
#pragma unroll
        for (int e = 0; e < 16; ++e) mx = fmaxf(mx, acc[kb][e]);
    mx = fmaxf(mx, __shfl_xor(mx, 32));
    const float ml = mx * 1.4426950408889634f; float sum = 0.f;
#pragma unroll
    for (int kb = 0; kb < 8; ++kb)
#pragma unroll
        for (int e = 0; e < 16; ++e) { const float p = __builtin_amdgcn_exp2f(acc[kb][e] * 1.4426950408889634f - ml); acc[kb][e] = p; sum += p; }
    sum += __shfl_xor(sum, 32);
    const float inv = 1.f / sum;
    bf16x8 pf[8][2];
#pragma unroll
    for (int kb = 0; kb < 8; ++kb)
#pragma unroll
        for (int s = 0; s < 2; ++s) { u32x4 p; p.x = cvtpk(acc[kb][8 * s], acc[kb][8 * s + 1]); p.y = cvtpk(acc[kb][8 * s + 2], acc[kb][8 * s + 3]); p.z = cvtpk(acc[kb][8 * s + 4], acc[kb][8 * s + 5]); p.w = cvtpk(acc[kb][8 * s + 6], acc[kb][8 * s + 7]);
            pf[kb][s] = __builtin_bit_cast(bf16x8, p); }
    __syncthreads();
    const int q4 = (lane & 15) >> 2, p4 = lane & 3, blk2 = (lane >> 4) & 1;
    const LAS unsigned char* vbase = lds + (4 * hh + q4) * 512 + 8 * (p4 & 1);
    bf16* orow = OA + (t0 + r) * 1024 + h * 256 + 4 * hh;
#pragma unroll
    for (int dg = 0; dg < 2; ++dg) {
        f32x16 y[4];
#pragma unroll
        for (int d4 = 0; d4 < 4; ++d4)
#pragma unroll
            for (int e = 0; e < 16; ++e) y[d4][e] = 0.f;
#pragma unroll
        for (int kb = 0; kb < 8; ++kb)
#pragma unroll
            for (int s = 0; s < 2; ++s)
#pragma unroll
                for (int d4 = 0; d4 < 4; ++d4) { const int dblk = dg * 4 + d4;
                    const int c = 4 * dblk + 2 * blk2 + (p4 >> 1);
                    const LAS unsigned char* ap = vbase + (32 * kb + 16 * s) * 512 + ((c ^ (q4 << 2)) << 4);
                    const s16x4 lo = vtr(ap), hi = vtr(ap + 8 * 512);
                    const bf16x8 vf = __builtin_shufflevector(lo, hi, 0, 1, 2, 3, 4, 5, 6, 7);
                    y[d4] = __builtin_amdgcn_mfma_f32_32x32x16_bf16(vf, pf[kb][s], y[d4], 0, 0, 0); }
#pragma unroll
        for (int d4 = 0; d4 < 4; ++d4)
#pragma unroll
            for (int g = 0; g < 4; ++g) { uint2 o; o.x = cvtpk(y[d4][4 * g] * inv, y[d4][4 * g + 1] * inv); o.y = cvtpk(y[d4][4 * g + 2] * inv, y[d4][4 * g + 3] * inv);
                *(uint2*)(orow + 32 * (dg * 4 + d4) + 8 * g) = o; }
    }
    __syncthreads();
}
}

namespace ret {
typedef float f32x16 __attribute__((ext_vector_type(16)));
typedef short s16x4 __attribute__((ext_vector_type(4)));
typedef short v4i16_t __attribute__((ext_vector_type(4)));
typedef short bf16x8 __attribute__((ext_vector_type(8)));
typedef unsigned u32x4 __attribute__((ext_vector_type(4)));
constexpr int KDB = 16384, VB = 32768, CHB = KDB + VB, L_RT0 = 2 * CHB, L_RT1 = L_RT0 + 16384;
__device__ __forceinline__ int crow(int i, int hh) { return (i & 3) + 8 * (i >> 2) + 4 * hh; }
__device__ __forceinline__ int fsw(int x) { return ((x & 1) << 2) | ((x >> 1) & 3); }
__device__ __forceinline__ s16x4 vtr(const LAS unsigned char* p) { return __builtin_bit_cast(s16x4, __builtin_amdgcn_ds_read_tr16_b64_v4i16((LAS v4i16_t*)p)); }
struct Gam { float gamma, g127, cd, cd512; };
__device__ __forceinline__ Gam gam_of(int h) { const float lg2 = __log2f(1.0f - __builtin_amdgcn_exp2f(-5.0f - (float)h)); Gam g; g.gamma = __builtin_amdgcn_exp2f(lg2); g.g127 = __builtin_amdgcn_exp2f(127.f * lg2); g.cd = __builtin_amdgcn_exp2f(128.f * lg2); g.cd512 = __builtin_amdgcn_exp2f(512.f * lg2); return g; }
struct Ln { int lane, r, hh, q4, p4, blk2, wid; };
__device__ __forceinline__ Ln ln_of() { Ln L; const int tid = threadIdx.x; L.lane = tid & 63; asm volatile("" : "+v"(L.lane));     L.r = L.lane & 31; L.hh = L.lane >> 5; L.q4 = (L.lane & 15) >> 2; L.p4 = L.lane & 3; L.blk2 = (L.lane >> 4) & 1; L.wid = __builtin_amdgcn_readfirstlane(tid >> 6); return L; }

__device__ __forceinline__ void stage_chunk(LAS unsigned char* dst, const bf16* KD, const bf16* VU, size_t t0, int h, const Ln& L) {
#pragma unroll
    for (int i = 0; i < 2; ++i) { const int blk = L.wid * 2 + i, row = 8 * blk + (L.lane >> 3), pos = L.lane & 7;
        __builtin_amdgcn_global_load_lds((const unsigned*)((const char*)(KD + (t0 + row) * 512 + h * 64) + ((pos ^ fsw((row >> 1) & 7)) << 4)), (LAS unsigned*)(dst + blk * 1024), 16, 0, 0); }
#pragma unroll
    for (int i = 0; i < 4; ++i) { const int blk = L.wid * 4 + i, row = 4 * blk + (L.lane >> 4), pos = L.lane & 15;
        __builtin_amdgcn_global_load_lds((const unsigned*)((const char*)(VU + (t0 + row) * 2048 + h * 128) + ((pos ^ ((row & 3) << 2)) << 4)), (LAS unsigned*)(dst + KDB + blk * 1024), 16, 0, 0); }
}
__device__ __forceinline__ bf16x8 kd_row(const LAS unsigned char* kd, int jb, int s, const Ln& L) { const int j = 32 * jb + L.r; return *(const LAS bf16x8*)(kd + j * 128 + (((2 * s + L.hh) ^ fsw((j >> 1) & 7)) << 4)); }
__device__ __forceinline__ bf16x8 rt_row(const LAS unsigned char* rt, int eblk, int s, const Ln& L) { const int e = 32 * eblk + L.r; return *(const LAS bf16x8*)(rt + e * 128 + (((2 * s + L.hh) ^ fsw((e >> 1) & 7)) << 4)); }
__device__ __forceinline__ bf16x8 vt_frag(const LAS unsigned char* v, int tk0, int eblk, const Ln& L) {
    const int row = tk0 + 4 * L.hh + L.q4, c = 4 * eblk + 2 * L.blk2 + (L.p4 >> 1);
    const LAS unsigned char* ap = v + row * 256 + ((c ^ (L.q4 << 2)) << 4) + 8 * (L.p4 & 1);
    const s16x4 lo = vtr(ap), hi = vtr(ap + 8 * 256);
    return __builtin_shufflevector(lo, hi, 0, 1, 2, 3, 4, 5, 6, 7);
}
__device__ __forceinline__ bf16x8 kdt_frag(const LAS unsigned char* kd, int tk0, int db, const Ln& L) {
    const int row = tk0 + 4 * L.hh + L.q4, row2 = row + 8, c8 = 4 * db + 2 * L.blk2 + (L.p4 >> 1);
    const s16x4 lo = vtr(kd + row * 128 + ((c8 ^ fsw((row >> 1) & 7)) << 4) + 8 * (L.p4 & 1));
    const s16x4 hi = vtr(kd + row2 * 128 + ((c8 ^ fsw((row2 >> 1) & 7)) << 4) + 8 * (L.p4 & 1));
    return __builtin_shufflevector(lo, hi, 0, 1, 2, 3, 4, 5, 6, 7);
}
__device__ __forceinline__ f32x16 kv_tile(const LAS unsigned char* ch, int eb, int db, const Ln& L) {
    f32x16 kv;
#pragma unroll
    for (int e = 0; e < 16; ++e) kv[e] = 0.f;
#pragma unroll
    for (int s = 0; s < 8; ++s) kv = __builtin_amdgcn_mfma_f32_32x32x16_bf16(vt_frag(ch + KDB, 16 * s, eb, L), kdt_frag(ch, 16 * s, db, L), kv, 0, 0, 0);
    return kv;
}
__device__ __forceinline__ void rt_write(LAS unsigned char* rt, const f32x16& acc, float scale, int eb, int db, const Ln& L) {
    const int d = 32 * db + L.r;
#pragma unroll
    for (int i = 0; i < 16; ++i) { const int e = 32 * eb + crow(i, L.hh);
        *(LAS unsigned short*)(rt + e * 128 + (((d >> 3) ^ fsw((e >> 1) & 7)) << 4) + (d & 7) * 2) = (unsigned short)f2bf(acc[i] * scale); }
}

__device__ __forceinline__ void ret_totals(LAS unsigned char* lds, const bf16* KD, const bf16* VU, float* TB, int unit) {
    const Ln L = ln_of(); const int seg = unit & 15, h = (unit >> 4) & 7, b = unit >> 7; const Gam G = gam_of(h);
    const size_t T0 = (size_t)b * SEQ + (size_t)seg * 512; const int eb = L.wid >> 1, db = L.wid & 1;
    f32x16 acc;
#pragma unroll
    for (int e = 0; e < 16; ++e) acc[e] = 0.f;
#pragma unroll 1
    for (int p = 0; p < 2; ++p) {
        stage_chunk(lds, KD, VU, T0 + (2 * p) * 128, h, L); stage_chunk(lds + CHB, KD, VU, T0 + (2 * p + 1) * 128, h, L);
        __syncthreads();
        const f32x16 kv0 = kv_tile(lds, eb, db, L); acc = acc * G.cd + kv0 * G.g127;
        const f32x16 kv1 = kv_tile(lds + CHB, eb, db, L); acc = acc * G.cd + kv1 * G.g127;
        __syncthreads();
    }
    float* tb = TB + ((size_t)unit * 8 + L.wid) * 1024 + L.lane;
#pragma unroll
    for (int i = 0; i < 16; ++i) tb[i * 64] = acc[i];
}

__device__ __forceinline__ void ret_out(LAS unsigned char* lds, const bf16* QD, const bf16* KD, bf16* VU, const bf16* GR, const float* TB, const float* gn_g, int unit) {
    const Ln L0 = ln_of(); const int seg = unit & 15, h = (unit >> 4) & 7, b = unit >> 7; const Gam G = gam_of(h);
    const size_t T0 = (size_t)b * SEQ + (size_t)seg * 512; const int eb = L0.wid >> 1, db = L0.wid & 1;
    const int ib = (L0.wid < 4) ? L0.wid : 7 - L0.wid, cc = L0.wid >> 2;
    f32x16 acc;
#pragma unroll
    for (int e = 0; e < 16; ++e) acc[e] = 0.f;
#pragma unroll 1
    for (int s = 0; s < seg; ++s) { const float* tb = TB + ((size_t)(unit - seg + s) * 8 + L0.wid) * 1024 + L0.lane;
#pragma unroll
        for (int i = 0; i < 16; ++i) acc[i] = acc[i] * G.cd512 + tb[i * 64]; }
#pragma unroll 1
    for (int p = 0; p < 2; ++p) {
        Ln L = ln_of();
        const size_t tq = T0 + (size_t)(2 * p + cc) * 128 + 32 * ib + L.r;
        bf16x8 qf[4];
#pragma unroll
        for (int s = 0; s < 4; ++s) qf[s] = *(const bf16x8*)(QD + tq * 512 + h * 64 + 16 * s + 8 * L.hh);
        stage_chunk(lds, KD, VU, T0 + (2 * p) * 128, h, L); stage_chunk(lds + CHB, KD, VU, T0 + (2 * p + 1) * 128, h, L);
        rt_write(lds + L_RT0, acc, G.gamma, eb, db, L);
        __syncthreads();
        L = ln_of();
        { const f32x16 kv0 = kv_tile(lds, eb, db, L); acc = acc * G.cd + kv0 * G.g127; }
        rt_write(lds + L_RT1, acc, G.gamma, eb, db, L);
        { const f32x16 kv1 = kv_tile(lds + CHB, eb, db, L); acc = acc * G.cd + kv1 * G.g127; }
        __syncthreads();
        L = ln_of();
        const LAS unsigned char* ch = lds + cc * CHB; const LAS unsigned char* rt = lds + (cc ? L_RT1 : L_RT0);
        f32x16 y[4];
#pragma unroll
        for (int eblk = 0; eblk < 4; ++eblk) {
#pragma unroll
            for (int e = 0; e < 16; ++e) y[eblk][e] = 0.f;
#pragma unroll
            for (int s = 0; s < 4; ++s) y[eblk] = __builtin_amdgcn_mfma_f32_32x32x16_bf16(rt_row(rt, eblk, s, L), qf[s], y[eblk], 0, 0, 0);
        }
#pragma unroll
        for (int jb = 0; jb < 4; ++jb) {
            if (jb <= ib) {
                f32x16 st;
#pragma unroll
                for (int e = 0; e < 16; ++e) st[e] = 0.f;
#pragma unroll
                for (int s = 0; s < 4; ++s) st = __builtin_amdgcn_mfma_f32_32x32x16_bf16(kd_row(ch, jb, s, L), qf[s], st, 0, 0, 0);
                if (jb == ib) {
#pragma unroll
                    for (int i = 0; i < 16; ++i) st[i] = (crow(i, L.hh) <= L.r) ? st[i] : 0.f;
                }
#pragma unroll
                for (int s2 = 0; s2 < 2; ++s2) { u32x4 pw; pw.x = cvtpk_s(st[8 * s2], st[8 * s2 + 1]); pw.y = cvtpk_s(st[8 * s2 + 2], st[8 * s2 + 3]); pw.z = cvtpk_s(st[8 * s2 + 4], st[8 * s2 + 5]); pw.w = cvtpk_s(st[8 * s2 + 6], st[8 * s2 + 7]);
                    const bf16x8 pf = __builtin_bit_cast(bf16x8, pw);
#pragma unroll
                    for (int eblk = 0; eblk < 4; ++eblk) y[eblk] = __builtin_amdgcn_mfma_f32_32x32x16_bf16(vt_frag(ch + KDB, 32 * jb + 16 * s2, eblk, L), pf, y[eblk], 0, 0, 0); }
            }
        }
        L = ln_of(); const size_t tq2 = T0 + (size_t)(2 * p + cc) * 128 + 32 * ib + L.r;
        float s1 = 0.f;
#pragma unroll
        for (int eblk = 0; eblk < 4; ++eblk)
#pragma unroll
            for (int e = 0; e < 16; ++e) s1 += y[eblk][e];
        s1 += __shfl_xor(s1, 32); const float mu = s1 * (1.f / 128.f);
        float s2 = 0.f;
#pragma unroll
        for (int eblk = 0; eblk < 4; ++eblk)
#pragma unroll
            for (int e = 0; e < 16; ++e) { const float dl = y[eblk][e] - mu; s2 += dl * dl; }
        s2 += __shfl_xor(s2, 32); const float rs = rsqrtf(s2 * (1.f / 128.f) + EPS);
#pragma unroll
        for (int eblk = 0; eblk < 4; ++eblk)
#pragma unroll
            for (int g = 0; g < 4; ++g) { const int e0 = h * 128 + 32 * eblk + 8 * g + 4 * L.hh;
                const uint2 gw = *(const uint2*)(GR + tq2 * 1024 + e0); const f32x4 gg = *(const f32x4*)(gn_g + e0);
                const float o0 = (y[eblk][4 * g] - mu) * rs * gg[0] * __uint_as_float(gw.x << 16), o1 = (y[eblk][4 * g + 1] - mu) * rs * gg[1] * __uint_as_float(gw.x & 0xffff0000u);
                const float o2 = (y[eblk][4 * g + 2] - mu) * rs * gg[2] * __uint_as_float(gw.y << 16), o3 = (y[eblk][4 * g + 3] - mu) * rs * gg[3] * __uint_as_float(gw.y & 0xffff0000u);
                uint2 o; o.x = cvtpk_s(o0, o1); o.y = cvtpk_s(o2, o3); *(uint2*)(VU + tq2 * 2048 + e0) = o;
                if (g & 1) asm volatile("" ::: "memory"); }
        __syncthreads();
    }
}
}

namespace s5 {
typedef float f32x16 __attribute__((ext_vector_type(16)));
typedef unsigned u32x2 __attribute__((ext_vector_type(2)));
typedef short s16x4 __attribute__((ext_vector_type(4)));
typedef short v4i16_t __attribute__((ext_vector_type(4)));
typedef short bf16x8 __attribute__((ext_vector_type(8)));
typedef unsigned u32x4 __attribute__((ext_vector_type(4)));
struct C2 { float r, i; };
__device__ __forceinline__ C2 cmul(C2 a, C2 b) { C2 o; o.r = a.r * b.r - a.i * b.i; o.i = a.r * b.i + a.i * b.r; return o; }
__device__ __forceinline__ C2 cfma(C2 a, C2 x, C2 b) { C2 o; o.r = a.r * x.r - a.i * x.i + b.r; o.i = a.r * x.i + a.i * x.r + b.i; return o; }
__device__ __forceinline__ s16x4 vtr(const LAS unsigned char* p) { return __builtin_bit_cast(s16x4, __builtin_amdgcn_ds_read_tr16_b64_v4i16((LAS v4i16_t*)p)); }
__device__ __forceinline__ bf16x8 pack8f(const float* p, float sgn) { const f32x4 a = *(const f32x4*)p, c = *(const f32x4*)(p + 4); u32x4 w; w.x = cvtpk_s(a[0] * sgn, a[1] * sgn); w.y = cvtpk_s(a[2] * sgn, a[3] * sgn); w.z = cvtpk_s(c[0] * sgn, c[1] * sgn); w.w = cvtpk_s(c[2] * sgn, c[3] * sgn); return __builtin_bit_cast(bf16x8, w); }
__device__ __forceinline__ float gelu_fast(float x) { const float u = 0.7978845608028654f * (x + 0.044715f * x * x * x); return x * __builtin_amdgcn_rcpf(1.f + __builtin_amdgcn_exp2f(-2.8853900817779268f * u)); }

template <bool OUT>
__device__ __forceinline__ void s5_unit(LAS unsigned char* img, const bf16* __restrict__ VU, const float* __restrict__ S5P, const float* __restrict__ c_re, const float* __restrict__ c_im,
                                        const float* __restrict__ dvec, float* XT, bf16* YG, int b, int g, int seg) {
    int lane = threadIdx.x & 63; asm volatile("" : "+v"(lane));
    const int r = lane & 31, hh = lane >> 5, i16 = lane & 15, kq = lane >> 4, q4 = i16 >> 2, p4 = i16 & 3;
    const size_t T0 = (size_t)b * SEQ + (size_t)seg * 512;
    const int wu = (b * SG + g) * 16 + seg;
    bf16x8 Bf[2][2];
#pragma unroll
    for (int nh = 0; nh < 2; ++nh)
#pragma unroll
        for (int ri = 0; ri < 2; ++ri) Bf[nh][ri] = pack8f(S5P + (ri ? S5P_BI : S5P_BR) + (g * 64 + 32 * nh + r) * 16 + 8 * hh, 1.f);
    C2 a1[2], a2[2], a3[2], a4[2], xin[2];
#pragma unroll
    for (int nh = 0; nh < 2; ++nh) { a1[nh].r = S5P[S5P_AR + g * 64 + 32 * nh + r]; a1[nh].i = S5P[S5P_AI + g * 64 + 32 * nh + r];
        a2[nh] = cmul(a1[nh], a1[nh]); a3[nh] = cmul(a2[nh], a1[nh]); a4[nh] = cmul(a2[nh], a2[nh]); xin[nh].r = 0.f; xin[nh].i = 0.f; }
    bf16x8 Cm[4], Dm;
    if (OUT) {
#pragma unroll
        for (int s = 0; s < 4; ++s) Cm[s] = pack8f((s < 2 ? c_re : c_im) + (g * 16 + i16) * 64 + 32 * (s & 1) + 8 * kq, s < 2 ? 1.f : -1.f);
        const float dv = dvec[g * 16 + i16]; u32x4 w;
        w.x = cvtpk_s((8 * kq + 0 == i16) ? dv : 0.f, (8 * kq + 1 == i16) ? dv : 0.f); w.y = cvtpk_s((8 * kq + 2 == i16) ? dv : 0.f, (8 * kq + 3 == i16) ? dv : 0.f);
        w.z = cvtpk_s((8 * kq + 4 == i16) ? dv : 0.f, (8 * kq + 5 == i16) ? dv : 0.f); w.w = cvtpk_s((8 * kq + 6 == i16) ? dv : 0.f, (8 * kq + 7 == i16) ? dv : 0.f);
        Dm = __builtin_bit_cast(bf16x8, w);
        C2 a512[2];
#pragma unroll
        for (int nh = 0; nh < 2; ++nh) { C2 t = a4[nh];
#pragma unroll
            for (int k = 0; k < 7; ++k) t = cmul(t, t);
            a512[nh] = t; }
#pragma unroll 1
        for (int s = 0; s < seg; ++s) { const float* xp = XT + (size_t)(wu - seg + s) * 128 + r;
#pragma unroll
            for (int nh = 0; nh < 2; ++nh) { C2 tv; tv.r = xp[(nh * 2) * 32]; tv.i = xp[(nh * 2 + 1) * 32]; xin[nh] = cfma(a512[nh], xin[nh], tv); } }
    }
    const bf16* ub = VU + T0 * 2048 + 1024 + g * 16;
    const bf16x8 zero8 = {0, 0, 0, 0, 0, 0, 0, 0};
    bf16x8 uA = *(const bf16x8*)(ub + (size_t)r * 2048 + 8 * hh), uD0 = zero8, uD1 = zero8;
    if (OUT && kq < 2) { uD0 = *(const bf16x8*)(ub + (size_t)i16 * 2048 + 8 * kq); uD1 = *(const bf16x8*)(ub + (size_t)(16 + i16) * 2048 + 8 * kq); }
#pragma unroll 1
    for (int blk = 0; blk < 16; ++blk) {
        const bf16x8 cA = uA, cD0 = uD0, cD1 = uD1;
        if (blk + 1 < 16) { const bf16* un = ub + (size_t)(blk + 1) * 32 * 2048;
            uA = *(const bf16x8*)(un + (size_t)r * 2048 + 8 * hh);
            if (OUT && kq < 2) { uD0 = *(const bf16x8*)(un + (size_t)i16 * 2048 + 8 * kq); uD1 = *(const bf16x8*)(un + (size_t)(16 + i16) * 2048 + 8 * kq); } }
        f32x16 X[2][2];
#pragma unroll
        for (int nh = 0; nh < 2; ++nh)
#pragma unroll
            for (int ri = 0; ri < 2; ++ri) { f32x16 z;
#pragma unroll
                for (int e = 0; e < 16; ++e) z[e] = 0.f;
                X[nh][ri] = __builtin_amdgcn_mfma_f32_32x32x16_bf16(cA, Bf[nh][ri], z, 0, 0, 0); }
#pragma unroll
        for (int nh = 0; nh < 2; ++nh) {
#pragma unroll
            for (int gi = 0; gi < 4; ++gi)
#pragma unroll
                for (int m = 1; m < 4; ++m) { C2 pv, bv; pv.r = X[nh][0][4 * gi + m - 1]; pv.i = X[nh][1][4 * gi + m - 1]; bv.r = X[nh][0][4 * gi + m]; bv.i = X[nh][1][4 * gi + m];
                    const C2 nv = cfma(a1[nh], pv, bv); X[nh][0][4 * gi + m] = nv.r; X[nh][1][4 * gi + m] = nv.i; }
            C2 carry[4]; C2 c = xin[nh];
#pragma unroll
            for (int gi = 0; gi < 4; ++gi) { C2 own, oth; own.r = X[nh][0][4 * gi + 3]; own.i = X[nh][1][4 * gi + 3];
                oth.r = __shfl_xor(own.r, 32); oth.i = __shfl_xor(own.i, 32);
                const C2 e0 = hh ? oth : own, e1 = hh ? own : oth;
                const C2 c0 = c; c = cfma(a4[nh], c, e0); const C2 c1 = c; c = cfma(a4[nh], c, e1);
                carry[gi] = hh ? c1 : c0; }
            xin[nh] = c;
            if (OUT) {
#pragma unroll
                for (int gi = 0; gi < 4; ++gi) { C2 lv, t;
                    lv.r = X[nh][0][4 * gi]; lv.i = X[nh][1][4 * gi]; t = cfma(a1[nh], carry[gi], lv); X[nh][0][4 * gi] = t.r; X[nh][1][4 * gi] = t.i;
                    lv.r = X[nh][0][4 * gi + 1]; lv.i = X[nh][1][4 * gi + 1]; t = cfma(a2[nh], carry[gi], lv); X[nh][0][4 * gi + 1] = t.r; X[nh][1][4 * gi + 1] = t.i;
                    lv.r = X[nh][0][4 * gi + 2]; lv.i = X[nh][1][4 * gi + 2]; t = cfma(a3[nh], carry[gi], lv); X[nh][0][4 * gi + 2] = t.r; X[nh][1][4 * gi + 2] = t.i;
                    lv.r = X[nh][0][4 * gi + 3]; lv.i = X[nh][1][4 * gi + 3]; t = cfma(a4[nh], carry[gi], lv); X[nh][0][4 * gi + 3] = t.r; X[nh][1][4 * gi + 3] = t.i; }
#pragma unroll
                for (int ri = 0; ri < 2; ++ri) { const int k = 64 * ri + 32 * nh + r; LAS unsigned char* rowp = img + k * 64;
#pragma unroll
                    for (int gi = 0; gi < 4; ++gi) { u32x2 w; w.x = cvtpk_s(X[nh][ri][4 * gi], X[nh][ri][4 * gi + 1]); w.y = cvtpk_s(X[nh][ri][4 * gi + 2], X[nh][ri][4 * gi + 3]);
                        *(LAS u32x2*)(rowp + (((2 * gi + hh) ^ ((k >> 1) & 7)) << 3)) = w; } }
            }
        }
        if (OUT) {
            asm volatile("s_waitcnt lgkmcnt(0)" ::: "memory");
            const size_t tok0 = T0 + (size_t)blk * 32;
#pragma unroll
            for (int tb = 0; tb < 2; ++tb) {
                f32x4 y = {0.f, 0.f, 0.f, 0.f};
#pragma unroll
                for (int s = 0; s < 4; ++s) { const int row = 32 * s + 8 * kq + q4, row2 = row + 4;
                    const s16x4 lo = vtr(img + row * 64 + (((4 * tb + p4) ^ ((row >> 1) & 7)) << 3)), hi = vtr(img + row2 * 64 + (((4 * tb + p4) ^ ((row2 >> 1) & 7)) << 3));
                    const bf16x8 xa = __builtin_shufflevector(lo, hi, 0, 1, 2, 3, 4, 5, 6, 7);
                    y = __builtin_amdgcn_mfma_f32_16x16x32_bf16(xa, Cm[s], y, 0, 0, 0); }
                y = __builtin_amdgcn_mfma_f32_16x16x32_bf16(tb ? cD1 : cD0, Dm, y, 0, 0, 0);
#pragma unroll
                for (int e = 0; e < 4; ++e) YG[(tok0 + 16 * tb + 4 * kq + e) * 1024 + g * 16 + i16] = (bf16)(cvtpk_s(gelu_fast(y[e]), 0.f) & 0xffffu);
            }
            asm volatile("s_waitcnt lgkmcnt(0)" ::: "memory");
        }
    }
    if (!OUT) { if (hh == 0) { float* xp = XT + (size_t)wu * 128 + r;
#pragma unroll
            for (int nh = 0; nh < 2; ++nh) { xp[(nh * 2) * 32] = xin[nh].r; xp[(nh * 2 + 1) * 32] = xin[nh].i; } } }
}
}

constexpr int NPHASES = 10;
__global__ void __launch_bounds__(NWAVES * 64, 2) skel_fwd(Args args) {
    extern __shared__ __attribute__((aligned(16))) unsigned char lds[];
    Frame F;
    F.lds = (LAS unsigned char*)lds;
    F.MISC = (volatile LAS unsigned*)(F.lds + MISC_OFF);
    F.tid = threadIdx.x; F.lane = F.tid & 63; F.wave = __builtin_amdgcn_readfirstlane(F.tid >> 6);
    F.G = gridDim.x; { const int bx = blockIdx.x; F.vcu = (F.G % 8 == 0) ? (bx % 8) * (F.G / 8) + bx / 8 : bx; }
    unsigned char* ws = args.ws;
    F.ctl = (gu32*)(ws + WS_CTL);
    const float* x = (const float*)args.in[0]; const float* mem = (const float*)args.in[1]; const int* pos = (const int*)args.in[2];
    const float* norm1_g = (const float*)args.in[3]; const float* w_in = (const float*)args.in[4];
    const float* s5_a_re = (const float*)args.in[6]; const float* s5_a_im = (const float*)args.in[7]; const float* s5_log_dt = (const float*)args.in[8];
    const float* s5_b_re = (const float*)args.in[9]; const float* s5_b_im = (const float*)args.in[10];
    const float* s5_glu_w = (const float*)args.in[14]; const float* w_out = (const float*)args.in[16]; const float* norm2_g = (const float*)args.in[17]; const float* norm_mem_g = (const float*)args.in[18];
    const float* xa_wq = (const float*)args.in[19]; const float* xa_wk = (const float*)args.in[20]; const float* xa_wv = (const float*)args.in[21]; const float* xa_wo = (const float*)args.in[22];
    bf16* HB = (bf16*)args.out;
    float* rope = (float*)(ws + WS_ROPE); float* S5P = (float*)(ws + WS_S5P);
    bf16* Q = (bf16*)(ws + WS_Q); bf16* Kb = (bf16*)(ws + WS_K); bf16* VU = (bf16*)(ws + WS_VU); bf16* GR = (bf16*)(ws + WS_GR); bf16* GS = (bf16*)(ws + WS_GS);
    bf16* MB = (bf16*)(ws + WS_MB); bf16* KA = (bf16*)(ws + WS_KA); bf16* VA = (bf16*)(ws + WS_VA); bf16* YG = (bf16*)args.out;
    bf16* X1B = (bf16*)(ws + WS_X1B); bf16* OA = (bf16*)(ws + WS_OA); bf16* QA = (bf16*)(ws + WS_QA); float* SSQ = (float*)(ws + WS_MISC); float* SSQ2 = (float*)(ws + WS_MISC + MiB);
    float* TB = (float*)(ws + WS_KVST); float* XT = (float*)(ws + WS_KVST + 16 * MiB);
    const float* s5_c_re = (const float*)args.in[11]; const float* s5_c_im = (const float*)args.in[12]; const float* s5_d = (const float*)args.in[13]; const float* ret_gn_g = (const float*)args.in[5];
    const float* s5_glu_b = (const float*)args.in[15]; const float* norm_f_g = (const float*)args.in[23];
    bf16* WIN_T = (bf16*)(ws + WS_WIN); bf16* WGLU_T = (bf16*)(ws + WS_WGLU); bf16* WOUT_T = (bf16*)(ws + WS_WOUT); bf16* WQ_T = (bf16*)(ws + WS_WQ); bf16* WKV_T = (bf16*)(ws + WS_WKV); bf16* WO_T = (bf16*)(ws + WS_WO);

    for (int u = F.tid; u < (LDS_BYTES - LDSCTL_OFF) / 4; u += NWAVES * 64) ((LAS unsigned*)(F.lds + LDSCTL_OFF))[u] = 0u;
    __syncthreads();
    XcdBarrier bar = xcd_barrier_post((unsigned*)(F.ctl + CW_BAR) + args.li * XCD_BAR_WORDS, F.MISC + 8);
    const int lo = args.ph_lo, hi = args.ph_hi;
#define IN(k) (lo <= (k) && (k) < hi)
#define BOTH(k) (IN(k) && IN((k) + 1))
#define GRID_BAR() xcd_barrier(bar)

    if (IN(0)) {
        LAS float* scr = (LAS float*)(F.lds + RING_OFF + F.wave * 16384);
        const int gw = F.vcu * NWAVES + F.wave, NGW = F.G * NWAVES;
        constexpr int I_IN = (D / 64) * (INC / 32), I_SQ = (D / 64) * (D / 32), I_OUT = (DMIX / 64) * (D / 32);
        constexpr int NITEMS = I_IN + 5 * I_SQ + I_OUT;
        for (int it = gw; it < NITEMS; it += NGW) {
            int r = it;
            if (r < I_IN) { p0_transpose_item<1>(w_in, D, INC, WIN_T, 0, norm1_g, scr, r, F.lane); continue; } r -= I_IN;
            if (r < I_OUT) { p0_transpose_item<0>(w_out, DMIX, D, WOUT_T, 0, nullptr, scr, r, F.lane); continue; } r -= I_OUT;
            if (r < I_SQ) { p0_transpose_item<0>(s5_glu_w, D, D, WGLU_T, 0, nullptr, scr, r, F.lane); continue; } r -= I_SQ;
            if (r < I_SQ) { p0_transpose_item<2>(xa_wq, D, D, WQ_T, 0, norm2_g, scr, r, F.lane); continue; } r -= I_SQ;
            if (r < I_SQ) { p0_transpose_item<0>(xa_wk, D, D, WKV_T, 0, norm_mem_g, scr, r, F.lane); continue; } r -= I_SQ;
            if (r < I_SQ) { p0_transpose_item<0>(xa_wv, D, D, WKV_T, D, norm_mem_g, scr, r, F.lane); continue; } r -= I_SQ;
            p0_transpose_item<0>(xa_wo, D, D, WO_T, 0, nullptr, scr, r, F.lane);
        }
        for (int m = gw; m < M; m += NGW) rms_row_to_bf16(x + (size_t)m * D, HB + (size_t)m * D, F.lane);
        for (int m = gw; m < MM; m += NGW) rms_row_to_bf16(mem + (size_t)m * D, MB + (size_t)m * D, F.lane);
        const int gt = F.vcu * (NWAVES * 64) + F.tid, NGT = F.G * NWAVES * 64;
        for (int idx = gt; idx < M * 32; idx += NGT) { const int t = idx >> 5, i = idx & 31;
            const float inv = powf(10000.0f, -(float)i / 32.0f); const float ang = (float)pos[t] * inv; float s, c; sincosf(ang, &s, &c);
            *(float2*)(rope + 2 * (size_t)idx) = make_float2(c, s); }
        for (int idx = gt; idx < SG * SN; idx += NGT) {
            const int g = idx / SN; const float dt = expf(s5_log_dt[g]), ar = s5_a_re[idx], ai = s5_a_im[idx];
            const float mag = expf(ar * dt); float sn, cs; sincosf(ai * dt, &sn, &cs);
            const float abr = mag * cs, abi = mag * sn, den = ar * ar + ai * ai, nr = abr - 1.f, ni = abi;
            const float fr = (nr * ar + ni * ai) / den, fi = (ni * ar - nr * ai) / den;
            S5P[S5P_AR + idx] = abr; S5P[S5P_AI + idx] = abi;
            for (int p = 0; p < SP; ++p) { const float br = s5_b_re[idx * SP + p], bi = s5_b_im[idx * SP + p];
                S5P[S5P_BR + idx * SP + p] = fr * br - fi * bi; S5P[S5P_BI + idx * SP + p] = fr * bi + fi * br; }
        }
        if (BOTH(0)) GRID_BAR();
    }
    if (IN(1)) {
        pg8::Gemm g{HB, WIN_T, M, INC, D}; pg8::StaticOrder S; S.init(M, INC, F.G, (int)blockIdx.x);
        pg8::EpInprojMK E{Q, Kb, VU, GR, GS, rope};
        pg8::gemm_phase<pg8::EpInprojMK, pg8::StaticOrder, true, true>(F.lds + RING_OFF, g, S, E);
        {
            pg8::Gemm g2{MB, WKV_T, MM, 2 * D, D}; pg8::StaticOrder S2; S2.init(MM, 2 * D, F.G, (int)blockIdx.x);
            pg8::EpBf16Split E2{KA, D, D, (size_t)(WS_VA - WS_KA) / 2};
            pg8::gemm_phase<pg8::EpBf16Split, pg8::StaticOrder, true, true>(F.lds + RING_OFF, g2, S2, E2);
        }
        if (BOTH(1)) GRID_BAR();
    }
    if (IN(2)) {
        for (int u = F.vcu; u < 256; u += F.G) s5::s5_unit<false>(F.lds + RING_OFF + F.wave * 8192, VU, S5P, s5_c_re, s5_c_im, s5_d, XT, YG, u >> 7, (u & 7) * 8 + F.wave, (u >> 3) & 15);
        __syncthreads();
        for (int u = F.vcu; u < 256; u += F.G) ret::ret_totals(F.lds + RING_OFF, Kb, VU, TB, u);
        if (BOTH(2)) GRID_BAR();
    }
    if (IN(3)) {
        for (int u = F.vcu; u < 256; u += F.G) s5::s5_unit<true>(F.lds + RING_OFF + F.wave * 8192, VU, S5P, s5_c_re, s5_c_im, s5_d, XT, YG, u >> 7, (u & 7) * 8 + F.wave, (u >> 3) & 15);
        __syncthreads();
        for (int u = F.vcu; u < 256; u += F.G) ret::ret_out(F.lds + RING_OFF, Q, Kb, VU, GR, TB, ret_gn_g, u);
        if (BOTH(3)) GRID_BAR();
    }
    if (IN(4)) {
        pg8::Gemm g{YG, WGLU_T, M, D, D}; pg8::StaticOrder S; S.init(M, D, F.G, (int)blockIdx.x);
        pg8::EpGluMK E{YG, GS, s5_glu_b, VU};
        pg8::gemm_phase<pg8::EpGluMK, pg8::StaticOrder, true, true>(F.lds + RING_OFF, g, S, E);
        if (BOTH(4)) GRID_BAR();
    }
    if (IN(5)) {
        pg8::Gemm g{VU, WOUT_T, M, D, DMIX}; pg8::StaticOrder S; S.init(M, D, F.G, (int)blockIdx.x);
        pg8::EpResMK E{x, args.out, X1B, SSQ};
        pg8::gemm_phase<pg8::EpResMK, pg8::StaticOrder, true, true>(F.lds + RING_OFF, g, S, E);
        if (BOTH(5)) GRID_BAR();
    }
    if (IN(6)) {
        pg8::Gemm g{X1B, WQ_T, M, D, D}; pg8::StaticOrder S; S.init(M, D, F.G, (int)blockIdx.x);
        pg8::EpQMK E{QA, SSQ};
        pg8::gemm_phase<pg8::EpQMK, pg8::StaticOrder, true, true>(F.lds + RING_OFF, g, S, E);
        if (BOTH(6)) GRID_BAR();
    }
    if (IN(7)) {
        for (int u = F.vcu; u < BATCH * XH * (SEQ / 256); u += F.G) xatt::attn_unit(F.lds + RING_OFF, QA, KA, VA, OA, u >> 7, (u >> 5) & 3, u & 31);
        if (BOTH(7)) GRID_BAR();
    }
    if (IN(8)) {
        pg8::Gemm g{OA, WO_T, M, D, D}; pg8::StaticOrder S; S.init(M, D, F.G, (int)blockIdx.x);
        pg8::EpResMK E{args.out, args.out, nullptr, SSQ2};
        pg8::gemm_phase<pg8::EpResMK, pg8::StaticOrder, true, true>(F.lds + RING_OFF, g, S, E);
        if (BOTH(8)) GRID_BAR();
    }
    if (IN(9)) {
        const int gw = F.vcu * NWAVES + F.wave, NGW = F.G * NWAVES;
        for (int m = gw; m < M; m += NGW) {
            const f32x4 s0 = *(const f32x4*)(SSQ2 + (size_t)m * 16), s1 = *(const f32x4*)(SSQ2 + (size_t)m * 16 + 4), s2 = *(const f32x4*)(SSQ2 + (size_t)m * 16 + 8), s3 = *(const f32x4*)(SSQ2 + (size_t)m * 16 + 12);
            const f32x4 st = (s0 + s1) + (s2 + s3); const float rs = rsqrtf(((st[0] + st[1]) + (st[2] + st[3])) * (1.f / 1024.f) + EPS);
            f32x4* xr = (f32x4*)(args.out + (size_t)m * D) + F.lane;
#pragma unroll
            for (int j = 0; j < 4; ++j) { const f32x4 gv = *((const f32x4*)norm_f_g + F.lane + 64 * j); xr[64 * j] = xr[64 * j] * rs * gv; }
        }
    }
#undef IN
#undef BOTH
#undef GRID_BAR
}

extern "C" void kernel_launch(void* const* d_in, const int* in_sizes, int n_in, void* d_out, int out_size, void* d_ws, size_t ws_size, hipStream_t stream) {
    const float* x = (const float*)d_in[0];
    const float* ret_gn_g = (const float*)d_in[5];
    const float* s5_c_re = (const float*)d_in[11]; const float* s5_c_im = (const float*)d_in[12];
    const float* s5_d = (const float*)d_in[13]; const float* s5_glu_w = (const float*)d_in[14]; const float* s5_glu_b = (const float*)d_in[15];
    const float* w_out = (const float*)d_in[16]; const float* norm2_g = (const float*)d_in[17]; const float* norm_mem_g = (const float*)d_in[18];
    const float* xa_wq = (const float*)d_in[19]; const float* xa_wk = (const float*)d_in[20]; const float* xa_wv = (const float*)d_in[21]; const float* xa_wo = (const float*)d_in[22];
    const float* norm_f_g = (const float*)d_in[23];
    unsigned char* ws = (unsigned char*)d_ws; float* out = (float*)d_out;
    bf16* YG = (bf16*)d_out;
    float* S5P = (float*)(ws + WS_S5P); float* rstd2 = (float*)(ws + WS_MISC);
    bf16* Q = (bf16*)(ws + WS_Q); bf16* Kb = (bf16*)(ws + WS_K); bf16* VU = (bf16*)(ws + WS_VU); bf16* GR = (bf16*)(ws + WS_GR); bf16* GS = (bf16*)(ws + WS_GS);
    float* KV = (float*)(ws + WS_KVST); bf16* MB = (bf16*)(ws + WS_MB); bf16* KA = (bf16*)(ws + WS_KA); bf16* VA = (bf16*)(ws + WS_VA);
    bf16* X1B = (bf16*)(ws + WS_X1B); bf16* OA = (bf16*)(ws + WS_OA); bf16* QA = (bf16*)(ws + WS_QA);

    static int grid = 0;
    if (grid == 0) {
        int dev = 0, cus = 0;
        if (hipGetDevice(&dev) != hipSuccess || hipDeviceGetAttribute(&cus, hipDeviceAttributeMultiprocessorCount, dev) != hipSuccess) { fprintf(stderr, "kernel_launch: device query failed\n"); grid = -1; return; }
        if (hipFuncSetAttribute((const void*)skel_fwd, hipFuncAttributeMaxDynamicSharedMemorySize, LDS_BYTES) != hipSuccess) { fprintf(stderr, "kernel_launch: hipFuncSetAttribute failed\n"); grid = -1; return; }
        (void)hipGetLastError();
        grid = cus;
    }
    if (grid < 0) return;
    (void)hipMemsetAsync(ws + WS_CTL, 0, CTL_ZERO_BYTES, stream);
    Args a{};
    for (int i = 0; i < 24; ++i) a.in[i] = d_in[i];
    a.out = out; a.ws = ws;
    a.ph_lo = 0; a.ph_hi = NPHASES; a.li = 0;
    hipLaunchKernelGGL(skel_fwd, dim3(grid), dim3(NWAVES * 64), LDS_BYTES, stream, a);
}
```
